# Optimizing an MI355X kernel written in HIP

```python
import jax, jax.numpy as jnp
from jax import lax
import numpy as np

D_MODEL = 2048
BATCH = 8
SEQ = 2048
DEPTH = 2

GLA_W = 3 * D_MODEL // 8
MLSTM_W = 3 * D_MODEL // 8
SGU_W = D_MODEL - GLA_W - MLSTM_W

GLA_HEADS = 4
GLA_DV = GLA_W // GLA_HEADS
GLA_DK = GLA_DV // 2
GLA_GATE_RANK = 16
GLA_GATE_TAU = 16.0

MLSTM_HEADS = 4
MLSTM_DV = MLSTM_W // MLSTM_HEADS
MLSTM_DK = MLSTM_DV // 2
CONV_WIDTH = 4

SGU_GROUPS = 4
SGU_CH = SGU_W // SGU_GROUPS
SGU_BLOCK = 128

REC_CHUNK = 64
D_FF = -(-8 * D_MODEL // 768) * 256
EPS = 1e-6

kernel_name = "hymba_style_gla_mlstm_gmlp_hybrid"


def _proj_sizes():
    gk = GLA_HEADS * GLA_DK
    mk = MLSTM_HEADS * MLSTM_DK
    return (gk, gk, GLA_W, GLA_W, GLA_GATE_RANK,
            mk, mk, MLSTM_W, MLSTM_W, MLSTM_HEADS, MLSTM_HEADS,
            SGU_W, SGU_W)


def rms_norm(x, g):
    xf = x.astype(jnp.float32)
    y = xf * lax.rsqrt(jnp.mean(xf * xf, axis=-1, keepdims=True) + EPS)
    return (y * g.astype(jnp.float32)).astype(x.dtype)


def to_chunks(t, c):
    b, s, h, d = t.shape
    return t.reshape(b, s // c, c, h, d).transpose(1, 0, 3, 2, 4)


def from_chunks(t):
    n, b, h, c, d = t.shape
    return t.transpose(1, 0, 3, 2, 4).reshape(b, n * c, h, d)


def gla_chunked(q, k, v, log_a):
    b, s, h, dk = q.shape
    dv = v.shape[-1]
    mask = jnp.tril(jnp.ones((REC_CHUNK, REC_CHUNK), dtype=bool))

    def step(state, inp):
        qb, kb, vb, ab = inp
        cum = jnp.cumsum(ab, axis=2)
        diff = cum[:, :, :, None, :] - cum[:, :, None, :, :]
        decay = jnp.exp(jnp.where(mask[:, :, None], diff, -jnp.inf))
        attn = jnp.einsum('bhtsd,bhsd->bhts', qb[:, :, :, None, :] * decay, kb)
        o = (jnp.einsum('bhts,bhsv->bhtv', attn, vb)
             + jnp.einsum('bhtd,bhdv->bhtv', qb * jnp.exp(cum), state))
        last = cum[:, :, -1:, :]
        k_dec = kb * jnp.exp(last - cum)
        state = state * jnp.exp(last[:, :, 0, :, None]) + jnp.einsum('bhsd,bhsv->bhdv', k_dec, vb)
        return state, o

    s0 = jnp.zeros((b, h, dk, dv), jnp.float32)
    _, o = lax.scan(step, s0, tuple(to_chunks(t, REC_CHUNK) for t in (q, k, v, log_a)))
    return from_chunks(o)


def mlstm_chunked(q, k, v, i_pre, log_f):
    b, s, h, dk = q.shape
    dv = v.shape[-1]
    n = s // REC_CHUNK
    mask = jnp.tril(jnp.ones((REC_CHUNK, REC_CHUNK), dtype=bool))
    gate_chunks = lambda g: g.reshape(b, n, REC_CHUNK, h).transpose(1, 0, 3, 2)

    def step(carry, inp):
        c_st, n_st, m_st = carry
        qb, kb, vb, ib, fb = inp
        cum = jnp.cumsum(fb, axis=-1)
        dmat = jnp.where(mask, cum[..., :, None] - cum[..., None, :] + ib[..., None, :], -jnp.inf)
        inter = cum + m_st[..., None]
        m_t = jnp.maximum(inter, jnp.max(dmat, axis=-1))
        w = jnp.exp(dmat - m_t[..., None])
        sc_inter = jnp.exp(inter - m_t)
        sc = jnp.einsum('bhtd,bhsd->bhts', qb, kb) * w
        num = (jnp.einsum('bhts,bhsv->bhtv', sc, vb)
               + sc_inter[..., None] * jnp.einsum('bhtd,bhdv->bhtv', qb, c_st))
        den = jnp.sum(sc, axis=-1) + sc_inter * jnp.einsum('bhtd,bhd->bht', qb, n_st)
        h_out = num / jnp.maximum(jnp.abs(den), jnp.exp(-m_t))[..., None]
        total = cum[..., -1]
        g = total[..., None] - cum + ib
        m_new = jnp.maximum(total + m_st, jnp.max(g, axis=-1))
        wj = jnp.exp(g - m_new[..., None])
        dprev = jnp.exp(total + m_st - m_new)
        c_new = dprev[..., None, None] * c_st + jnp.einsum('bhs,bhsd,bhsv->bhdv', wj, kb, vb)
        n_new = dprev[..., None] * n_st + jnp.einsum('bhs,bhsd->bhd', wj, kb)
        return (c_new, n_new, m_new), h_out

    init = (jnp.zeros((b, h, dk, dv), jnp.float32),
            jnp.zeros((b, h, dk), jnp.float32),
            jnp.zeros((b, h), jnp.float32))
    xs = (to_chunks(q, REC_CHUNK), to_chunks(k, REC_CHUNK), to_chunks(v, REC_CHUNK),
          gate_chunks(i_pre), gate_chunks(log_f))
    _, hs = lax.scan(step, init, xs)
    return from_chunks(hs)


def causal_dwconv(x, w):
    kw = w.shape[0]
    s = x.shape[1]
    xp = jnp.pad(x, ((0, 0), (kw - 1, 0), (0, 0)))
    return sum(xp[:, j:j + s] * w[j] for j in range(kw))


def spatial_gating(u, v, w_s, b_s, ln_g, ln_b):
    b, s, _ = v.shape
    vf = v.astype(jnp.float32)
    mu = jnp.mean(vf, axis=-1, keepdims=True)
    var = jnp.mean(jnp.square(vf - mu), axis=-1, keepdims=True)
    vn = ((vf - mu) * lax.rsqrt(var + EPS) * ln_g + ln_b).astype(v.dtype)
    vb = vn.reshape(b, s // SGU_BLOCK, SGU_BLOCK, SGU_GROUPS, SGU_CH)
    w_causal = jnp.tril(w_s)
    mixed = jnp.einsum('gts,bnsgc->bntgc', w_causal, vb) + b_s.T[None, None, :, :, None]
    return u * mixed.reshape(b, s, SGU_W)


def hybrid_layer(x, norm_mix, w_in, gla_a2, gla_ab, gla_norm, ml_conv, ml_ib, ml_fb, ml_norm,
                 sgu_ln_g, sgu_ln_b, sgu_w, sgu_b, w_out, norm_ffn, w_gu, w_down):
    f32 = jnp.float32
    b, s, _ = x.shape
    h = rms_norm(x, norm_mix)
    proj = h @ w_in
    idx = np.cumsum(_proj_sizes())[:-1].tolist()
    (gq, gk, gv, gg, ga1, mq, mk, mv, mo, mi, mf, su, sv) = jnp.split(proj, idx, axis=-1)

    q = gq.reshape(b, s, GLA_HEADS, GLA_DK).astype(f32) * (GLA_DK ** -0.5)
    k = gk.reshape(b, s, GLA_HEADS, GLA_DK).astype(f32)
    v = gv.reshape(b, s, GLA_HEADS, GLA_DV).astype(f32)
    log_a = jax.nn.log_sigmoid((ga1 @ gla_a2 + gla_ab).astype(f32)) / GLA_GATE_TAU
    log_a = log_a.reshape(b, s, GLA_HEADS, GLA_DK)
    o_gla = gla_chunked(q, k, v, log_a)
    o_gla = rms_norm(o_gla, gla_norm.reshape(GLA_HEADS, GLA_DV)).reshape(b, s, GLA_W)
    out_a = o_gla * jax.nn.silu(gg.astype(f32))

    mqk = jax.nn.silu(causal_dwconv(jnp.concatenate([mq, mk], axis=-1), ml_conv))
    mq2, mk2 = jnp.split(mqk, 2, axis=-1)
    qm = mq2.reshape(b, s, MLSTM_HEADS, MLSTM_DK).astype(f32)
    km = mk2.reshape(b, s, MLSTM_HEADS, MLSTM_DK).astype(f32) * (MLSTM_DK ** -0.5)
    vm = mv.reshape(b, s, MLSTM_HEADS, MLSTM_DV).astype(f32)
    i_pre = (mi + ml_ib).astype(f32)
    log_f = jax.nn.log_sigmoid((mf + ml_fb).astype(f32))
    o_ml = mlstm_chunked(qm, km, vm, i_pre, log_f)
    o_ml = rms_norm(o_ml, ml_norm.reshape(MLSTM_HEADS, MLSTM_DV)).reshape(b, s, MLSTM_W)
    out_b = o_ml * jax.nn.sigmoid(mo.astype(f32))

    out_c = spatial_gating(jax.nn.gelu(su), jax.nn.gelu(sv), sgu_w, sgu_b, sgu_ln_g, sgu_ln_b)

    mix = jnp.concatenate([out_a.astype(x.dtype), out_b.astype(x.dtype), out_c.astype(x.dtype)], axis=-1)
    x = x + mix @ w_out

    hf = rms_norm(x, norm_ffn)
    gate, up = jnp.split(hf @ w_gu, 2, axis=-1)
    return x + (jax.nn.silu(gate) * up) @ w_down


def setup_inputs(seed: int = 0) -> dict:
    key = jax.random.key(seed)
    ks = jax.random.split(key, 20)
    L, D = DEPTH, D_MODEL
    nrm = lambda k, shape, scale: jax.random.normal(k, shape, jnp.float32) * scale
    p = sum(_proj_sizes())
    gk = GLA_HEADS * GLA_DK
    mk = MLSTM_HEADS * MLSTM_DK
    return {
        "x": nrm(ks[0], (BATCH, SEQ, D), 1.0),
        "norm_mix": 1.0 + nrm(ks[1], (L, D), 0.1),
        "w_in": nrm(ks[2], (L, D, p), D ** -0.5),
        "gla_a2": nrm(ks[3], (L, GLA_GATE_RANK, gk), GLA_GATE_RANK ** -0.5),
        "gla_ab": nrm(ks[4], (L, gk), 0.1),
        "gla_norm": 1.0 + nrm(ks[5], (L, GLA_W), 0.1),
        "ml_conv": nrm(ks[6], (L, CONV_WIDTH, 2 * mk), CONV_WIDTH ** -0.5),
        "ml_ib": nrm(ks[7], (L, MLSTM_HEADS), 0.1),
        "ml_fb": 3.0 + 3.0 * jax.random.uniform(ks[8], (L, MLSTM_HEADS), jnp.float32),
        "ml_norm": 1.0 + nrm(ks[9], (L, MLSTM_W), 0.1),
        "sgu_ln_g": 1.0 + nrm(ks[10], (L, SGU_W), 0.1),
        "sgu_ln_b": nrm(ks[11], (L, SGU_W), 0.1),
        "sgu_w": nrm(ks[12], (L, SGU_GROUPS, SGU_BLOCK, SGU_BLOCK), SGU_BLOCK ** -0.5),
        "sgu_b": 1.0 + nrm(ks[13], (L, SGU_GROUPS, SGU_BLOCK), 0.1),
        "w_out": nrm(ks[14], (L, D, D), D ** -0.5),
        "norm_ffn": 1.0 + nrm(ks[15], (L, D), 0.1),
        "w_gu": nrm(ks[16], (L, D, 2 * D_FF), D ** -0.5),
        "w_down": nrm(ks[17], (L, D_FF, D), D_FF ** -0.5),
        "norm_final": 1.0 + nrm(ks[18], (D,), 0.1),
    }


def reference(x, norm_mix, w_in, gla_a2, gla_ab, gla_norm, ml_conv, ml_ib, ml_fb, ml_norm,
              sgu_ln_g, sgu_ln_b, sgu_w, sgu_b, w_out, norm_ffn, w_gu, w_down, norm_final):
    for l in range(DEPTH):
        x = hybrid_layer(x, norm_mix[l], w_in[l], gla_a2[l], gla_ab[l], gla_norm[l],
                         ml_conv[l], ml_ib[l], ml_fb[l], ml_norm[l],
                         sgu_ln_g[l], sgu_ln_b[l], sgu_w[l], sgu_b[l],
                         w_out[l], norm_ffn[l], w_gu[l], w_down[l])
    return rms_norm(x, norm_final)
```

```cpp
#include <hip/hip_runtime.h>
#include <hip/hip_cooperative_groups.h>
#include <cstdio>
#include <cstdint>
namespace cg = cooperative_groups;
namespace pg8 {
#define PG8_LAS __attribute__((address_space(3)))
typedef unsigned short bf16_t;
typedef short bf16x8 __attribute__((ext_vector_type(8)));
typedef float f32x4 __attribute__((ext_vector_type(4)));
typedef unsigned u32x4 __attribute__((ext_vector_type(4)));
constexpr int BM = 256, BK = 64, HALF = 128, HTB = HALF * BK * 2  , STAGE_BYTES = 8 * HTB, NXCD = 8, WGM = 8;

__host__ __device__ __forceinline__ int lds_byte(int r, int c) { const int st = (r >> 4) * 2 + (c >> 5), rr = r & 15, cc = c & 31, ob = rr * 64 + cc * 2; return st * 1024 + (ob ^ (((ob >> 9) & 1) << 5)); }
__host__ __device__ __forceinline__ void stage_rc(int b, int& R, int& C) { const int st = b / 1024, sb = b % 1024, swz = sb ^ (((sb >> 9) & 1) << 5); R = (st >> 1) * 16 + swz / 64; C = (st & 1) * 32 + (swz % 64) / 2; }
__host__ __device__ __forceinline__ int perm32(int rho) { const int n = rho >> 4, i = rho & 15; return 8 * (i >> 2) + 4 * n + (i & 3); }

struct Unit { int pm, pn; };
struct Gemm { const bf16_t* A; const bf16_t* Bt; int M, N, K; };

struct StaticOrder {
    int nM, nN, nwg, G, c;
    __host__ __device__ void init(int M, int N, int G_, int c_) { nM = M / BM; nN = N / BM; nwg = nM * nN; G = G_; c = c_; }
    __host__ __device__ bool next(int i, Unit& u) const {
        const long L = (long)i * G + c; if (L >= nwg) return false;
        int wgid = (int)L; { const int q = nwg / NXCD, r = nwg % NXCD, xcd = wgid % NXCD, off = wgid / NXCD; wgid = (xcd < r ? xcd * (q + 1) : r * (q + 1) + (xcd - r) * q) + off; }
        const int nig = WGM * nN, gid = wgid / nig, fm = gid * WGM, gsz = (nM - fm) < WGM ? (nM - fm) : WGM;
        u.pm = fm + ((wgid % nig) % gsz); u.pn = (wgid % nig) / gsz; return true;
    }
    __device__ __forceinline__ void a_ready(const Unit&) const {}
    __device__ __forceinline__ void done(const Unit&) const {}
};
__device__ __forceinline__ unsigned cvt_pk_bf16(float lo, float hi) { unsigned r; asm volatile("v_cvt_pk_bf16_f32 %0, %1, %2" : "=v"(r) : "v"(lo), "v"(hi)); return r; }
typedef unsigned u32x2 __attribute__((ext_vector_type(2)));
struct EpiBf16 {
    static constexpr bool PERM = true, AFTER_DRAIN = false;
    bf16_t* O; int ldc;
    __device__ __forceinline__ void operator()(const f32x4 (&acc)[2][2][4][2], const Unit& u, int wr, int wc, int fr, int fq) const {
        const int row0 = u.pm * BM + wr * 64 + fr; const int col0 = u.pn * BM + wc * 32 + 8 * fq;
#pragma unroll
        for (int ai = 0; ai < 2; ++ai)
#pragma unroll
            for (int m = 0; m < 4; ++m) { bf16_t* rowp = O + (size_t)(row0 + ai * HALF + m * 16) * ldc + col0;
#pragma unroll
                for (int bj = 0; bj < 2; ++bj) { const f32x4 v0 = acc[ai][bj][m][0], v1 = acc[ai][bj][m][1];
                    u32x4 w; w.x = cvt_pk_bf16(v0[0], v0[1]); w.y = cvt_pk_bf16(v0[2], v0[3]); w.z = cvt_pk_bf16(v1[0], v1[1]); w.w = cvt_pk_bf16(v1[2], v1[3]);
                    *(u32x4*)(rowp + bj * HALF) = w; } }
    }
};
struct EpiResid {
    static constexpr bool PERM = false, AFTER_DRAIN = false;
    const float* basef; float* outf; int ldc; bf16_t* xb; unsigned long long* ssq;
    __device__ __forceinline__ void operator()(const f32x4 (&acc)[2][2][4][2], const Unit& u, int wr, int wc, int fr, int fq) const {
        const int row0 = u.pm * BM + wr * 64 + fr, col0 = u.pn * BM + wc * 32 + 4 * fq;
#pragma unroll
        for (int ai = 0; ai < 2; ++ai) {
            f32x4 bs[4][2][2];
            if (basef) {
#pragma unroll
                for (int m = 0; m < 4; ++m) { const size_t off = (size_t)(row0 + ai * HALF + m * 16) * ldc + col0;
#pragma unroll
                    for (int bj = 0; bj < 2; ++bj)
#pragma unroll
                        for (int n = 0; n < 2; ++n) bs[m][bj][n] = __builtin_nontemporal_load((const f32x4*)(basef + off + bj * HALF + n * 16)); }
            } else {
                u32x2 bw[4][2][2];
#pragma unroll
                for (int m = 0; m < 4; ++m) { const size_t off = (size_t)(row0 + ai * HALF + m * 16) * ldc + col0;
#pragma unroll
                    for (int bj = 0; bj < 2; ++bj)
#pragma unroll
                        for (int n = 0; n < 2; ++n) bw[m][bj][n] = *(const u32x2*)(xb + off + bj * HALF + n * 16); }
#pragma unroll
                for (int m = 0; m < 4; ++m)
#pragma unroll
                    for (int bj = 0; bj < 2; ++bj)
#pragma unroll
                        for (int n = 0; n < 2; ++n) { const u32x2 w = bw[m][bj][n];
                            bs[m][bj][n] = (f32x4){__uint_as_float(w.x << 16), __uint_as_float(w.x & 0xffff0000u), __uint_as_float(w.y << 16), __uint_as_float(w.y & 0xffff0000u)}; }
            }
#pragma unroll
            for (int m = 0; m < 4; ++m) { const int row = row0 + ai * HALF + m * 16; const size_t off = (size_t)row * ldc + col0;
                float s = 0.f;
#pragma unroll
                for (int bj = 0; bj < 2; ++bj)
#pragma unroll
                    for (int n = 0; n < 2; ++n) { const f32x4 y = bs[m][bj][n] + acc[ai][bj][m][n];
                        if (outf) __builtin_nontemporal_store(y, (f32x4*)(outf + off + bj * HALF + n * 16));
                        else { u32x2 w; w.x = cvt_pk_bf16(y[0], y[1]); w.y = cvt_pk_bf16(y[2], y[3]); *(u32x2*)(xb + off + bj * HALF + n * 16) = w; }
                        s += (y[0] * y[0] + y[1] * y[1]) + (y[2] * y[2] + y[3] * y[3]); }
                s += __shfl_xor(s, 16); s += __shfl_xor(s, 32);
                if (fq == 0) atomicAdd(ssq + row, (unsigned long long)(s * 1048576.0f + 0.5f)); }
            asm volatile("" ::: "memory");
        }
    }
};
struct EpiSwiGLU {
    static constexpr bool PERM = true, AFTER_DRAIN = false;
    bf16_t* O; int ldc; const unsigned long long* ssq; float invd, eps;
    __device__ __forceinline__ void operator()(const f32x4 (&acc)[2][2][4][2], const Unit& u, int wr, int wc, int fr, int fq) const {
        const int row0 = u.pm * BM + wr * 64 + fr; const int col0 = u.pn * HALF + wc * 32 + 8 * fq;
        float rsv[2][4];
#pragma unroll
        for (int ai = 0; ai < 2; ++ai)
#pragma unroll
            for (int m = 0; m < 4; ++m) rsv[ai][m] = (float)ssq[row0 + ai * HALF + m * 16] * (1.0f / 1048576.0f);
#pragma unroll
        for (int ai = 0; ai < 2; ++ai)
#pragma unroll
            for (int m = 0; m < 4; ++m) rsv[ai][m] = 1.0f / sqrtf(rsv[ai][m] * invd + eps);
#pragma unroll
        for (int ai = 0; ai < 2; ++ai)
#pragma unroll
            for (int m = 0; m < 4; ++m) { bf16_t* rowp = O + (size_t)(row0 + ai * HALF + m * 16) * ldc + col0;
                const float rs = rsv[ai][m];
                float r[8];
#pragma unroll
                for (int n = 0; n < 2; ++n)
#pragma unroll
                    for (int j = 0; j < 4; ++j) { const float gt = acc[ai][0][m][n][j] * rs, up = acc[ai][1][m][n][j] * rs;
                        r[n * 4 + j] = gt * __builtin_amdgcn_rcpf(1.0f + __expf(-gt)) * up; }
                u32x4 w; w.x = cvt_pk_bf16(r[0], r[1]); w.y = cvt_pk_bf16(r[2], r[3]); w.z = cvt_pk_bf16(r[4], r[5]); w.w = cvt_pk_bf16(r[6], r[7]);
                *(u32x4*)rowp = w; }
    }
};

struct EpiProj {
    static constexpr bool PERM = true, AFTER_DRAIN = false;
    bf16_t* O; int ldc; const float* cs1; const float* cs2;
    const unsigned long long* ssq; float invd, eps;
    __device__ __forceinline__ void operator()(const f32x4 (&acc)[2][2][4][2], const Unit& u, int wr, int wc, int fr, int fq) const {
        const int row0 = u.pm * BM + wr * 64 + fr; const int col0 = u.pn * BM + wc * 32 + 8 * fq;
        const int kind = (u.pn >= 6 && u.pn < 9) ? 1 : (u.pn >= 15 && u.pn < 18) ? 2 : (u.pn >= 18 && u.pn < 22) ? 3 : 0;
        float rsv[2][4];
#pragma unroll
        for (int ai = 0; ai < 2; ++ai)
#pragma unroll
            for (int m = 0; m < 4; ++m) rsv[ai][m] = (float)ssq[row0 + ai * HALF + m * 16] * (1.0f / 1048576.0f);
#pragma unroll
        for (int ai = 0; ai < 2; ++ai)
#pragma unroll
            for (int m = 0; m < 4; ++m) rsv[ai][m] = 1.0f / sqrtf(rsv[ai][m] * invd + eps);
        f32x4 sc[2][2];
#pragma unroll
        for (int bj = 0; bj < 2; ++bj)
#pragma unroll
            for (int n = 0; n < 2; ++n) sc[bj][n] = (f32x4){1.f, 1.f, 1.f, 1.f};
        if (kind == 1 || kind == 2) { const float* cs = (kind == 1) ? cs1 + (col0 - 6 * BM) : cs2 + (col0 - 15 * BM);
#pragma unroll
            for (int bj = 0; bj < 2; ++bj)
#pragma unroll
                for (int n = 0; n < 2; ++n) sc[bj][n] = *(const f32x4*)(cs + bj * HALF + 4 * n); }
#pragma unroll
        for (int ai = 0; ai < 2; ++ai)
#pragma unroll
            for (int m = 0; m < 4; ++m) { bf16_t* rowp = O + (size_t)(row0 + ai * HALF + m * 16) * ldc + col0;
                const float rs = rsv[ai][m];
#pragma unroll
                for (int bj = 0; bj < 2; ++bj) { if (u.pn == 22 && (bj != 0 || wc != 0)) continue;
                    f32x4 v[2] = {acc[ai][bj][m][0] * rs, acc[ai][bj][m][1] * rs};
                    if (kind != 0) {
#pragma unroll
                        for (int n = 0; n < 2; ++n)
#pragma unroll
                            for (int j = 0; j < 4; ++j) { const float x = v[n][j];
                                const float z = (kind == 3) ? 1.5957691216057308f * (x + 0.044715f * x * x * x) : x;
                                const float sg = __builtin_amdgcn_rcpf(1.0f + __expf(-z));
                                v[n][j] = ((kind == 2) ? sg : x * sg) * sc[bj][n][j]; }
                    }
                    u32x4 w; w.x = cvt_pk_bf16(v[0][0], v[0][1]); w.y = cvt_pk_bf16(v[0][2], v[0][3]); w.z = cvt_pk_bf16(v[1][0], v[1][1]); w.w = cvt_pk_bf16(v[1][2], v[1][3]);
                    *(u32x4*)(rowp + bj * HALF) = w; } }
    }
};
template <class Epi, class Sched, bool ALIGN_EPI = false, bool SP2 = false>
__device__ __forceinline__ void gemm_phase(PG8_LAS unsigned char* lds, const Gemm g, const Sched& S, const Epi& E) {
    int tid_ = threadIdx.x; asm volatile("" : "+v"(tid_)); const int tid = tid_, wid = __builtin_amdgcn_readfirstlane(tid >> 6), lane = tid & 63, wr = wid >> 2, wc = wid & 3, fr = lane & 15, fq = lane >> 4;
    const int K = g.K, nt = K / BK;
    unsigned voffA[2], voffB[2];
#pragma unroll
    for (int i = 0; i < 2; ++i) { int R, C; stage_rc(tid * 16 + i * 8192, R, C); const int Rb = Epi::PERM ? ((R & ~31) + perm32(R & 31)) : R;
        voffA[i] = (unsigned)(R * K + C) * 2u; voffB[i] = (unsigned)(Rb * K + C) * 2u; }
    const size_t kstep = (size_t)(BK * 2);
    const size_t hstep = (size_t)HALF * K * 2;
    const size_t tstep = 2 * hstep;
    const unsigned ldsw = (unsigned)wid * 1024u;
    const int aoff = lds_byte(wr * 64 + fr, fq * 8), boff = lds_byte(wc * 32 + fr, fq * 8);
#define PG8_SA(b, h) (((b) * 2 + (h)) * HTB)
#define PG8_SB(b, h) ((4 + (b) * 2 + (h)) * HTB)
#define PG8_STAGE(bufoff, gbase, voff) do { _Pragma("unroll") for (int _i = 0; _i < 2; ++_i) \
        __builtin_amdgcn_global_load_lds((const unsigned*)((const char*)(gbase) + (voff)[_i]), (PG8_LAS unsigned*)(lds + (bufoff) + ldsw + _i * 8192), 16, 0, 0); } while (0)
#define PG8_LDA(dst, b, h) do { _Pragma("unroll") for (int m = 0; m < 4; ++m) _Pragma("unroll") for (int k = 0; k < 2; ++k) dst[m][k] = *(const PG8_LAS bf16x8*)(lds + PG8_SA(b, h) + aoff + m * 2048 + k * 1024); } while (0)
#define PG8_LDB(dst, b, h) do { _Pragma("unroll") for (int n = 0; n < 2; ++n) _Pragma("unroll") for (int k = 0; k < 2; ++k) dst[n][k] = *(const PG8_LAS bf16x8*)(lds + PG8_SB(b, h) + boff + n * 2048 + k * 1024); } while (0)
#define PG8_MMA(ai, bj, At, Bt) do { __builtin_amdgcn_s_setprio(1); _Pragma("unroll") for (int m = 0; m < 4; ++m) _Pragma("unroll") for (int n = 0; n < 2; ++n) _Pragma("unroll") for (int k = 0; k < 2; ++k) \
        acc[ai][bj][m][n] = __builtin_amdgcn_mfma_f32_16x16x32_bf16(Bt[n][k], At[m][k], acc[ai][bj][m][n], 0, 0, 0); __builtin_amdgcn_s_setprio(0); } while (0)
#define PG8_WAIT_V(n) asm volatile("s_waitcnt vmcnt(" #n ")" ::: "memory")
#define PG8_WAIT_L(n) asm volatile("s_waitcnt lgkmcnt(" #n ")" ::: "memory")
#define PG8_BAR __builtin_amdgcn_s_barrier()
#define PG8_SCHED __builtin_amdgcn_sched_barrier(0)
    Unit cur, nxt; int ui = 0;
    if (!S.next(0, cur)) return;
    f32x4 acc[2][2][4][2];
#pragma unroll
    for (int a = 0; a < 2; ++a)
#pragma unroll
        for (int b = 0; b < 2; ++b)
#pragma unroll
            for (int m = 0; m < 4; ++m)
#pragma unroll
                for (int n = 0; n < 2; ++n) acc[a][b][m][n] = (f32x4){0.f, 0.f, 0.f, 0.f};
    bf16x8 At[4][2], B0[2][2], B1[2][2];
    const char* cA = (const char*)g.A + (size_t)cur.pm * tstep; const char* cB = (const char*)g.Bt + (size_t)cur.pn * tstep;
    S.a_ready(cur);
    if constexpr (SP2) {
        PG8_STAGE(PG8_SB(0, 0), cB, voffB); PG8_STAGE(PG8_SB(0, 1), cB + hstep, voffB); PG8_STAGE(PG8_SA(0, 0), cA, voffA); PG8_STAGE(PG8_SA(0, 1), cA + hstep, voffA);
        if (wr == 1) PG8_BAR;
        PG8_WAIT_V(2); PG8_BAR;
        PG8_STAGE(PG8_SB(1, 0), cB + kstep, voffB); PG8_STAGE(PG8_SA(1, 0), cA + kstep, voffA); PG8_STAGE(PG8_SB(1, 1), cB + hstep + kstep, voffB);
        PG8_WAIT_V(6); PG8_BAR;
    } else {
        PG8_STAGE(PG8_SB(0, 0), cB, voffB); PG8_STAGE(PG8_SA(0, 0), cA, voffA); PG8_STAGE(PG8_SB(0, 1), cB + hstep, voffB); PG8_STAGE(PG8_SA(0, 1), cA + hstep, voffA);
        if (wr == 1) PG8_BAR;
        PG8_WAIT_V(4); PG8_BAR;
        PG8_STAGE(PG8_SB(1, 0), cB + kstep, voffB); PG8_STAGE(PG8_SA(1, 0), cA + kstep, voffA); PG8_STAGE(PG8_SB(1, 1), cB + hstep + kstep, voffB);
        PG8_WAIT_V(6); PG8_BAR;
    }
    for (;;) {
        const bool has_next = S.next(ui + 1, nxt);
        const char* nA = has_next ? (const char*)g.A + (size_t)nxt.pm * tstep : cA; const char* nB = has_next ? (const char*)g.Bt + (size_t)nxt.pn * tstep : cB;
        for (int t = 0; t < nt; t += 2) {
            const bool last = (t == nt - 2);
            const char* a1 = cA + (size_t)(t + 1) * kstep;
            const char* a2 = last ? nA : cA + (size_t)(t + 2) * kstep; const char* b2 = last ? nB : cB + (size_t)(t + 2) * kstep;
            const char* a3 = a2 + kstep; const char* b3 = b2 + kstep;
            if (last && has_next) S.a_ready(nxt);
            if constexpr (SP2) {
            PG8_LDB(B0, 0, 0); PG8_LDB(B1, 0, 1); PG8_SCHED; PG8_LDA(At, 0, 0); PG8_STAGE(PG8_SA(1, 1), a1 + hstep, voffA);
            PG8_WAIT_V(8); PG8_WAIT_L(0); PG8_BAR; PG8_MMA(0, 0, At, B0); PG8_MMA(0, 1, At, B1); PG8_BAR; PG8_SCHED;
            PG8_LDA(At, 0, 1); PG8_STAGE(PG8_SB(0, 0), b2, voffB); PG8_STAGE(PG8_SB(0, 1), b2 + hstep, voffB); PG8_STAGE(PG8_SA(0, 0), a2, voffA);
            PG8_WAIT_V(8); PG8_WAIT_L(0); PG8_BAR; PG8_MMA(1, 0, At, B0); PG8_MMA(1, 1, At, B1); PG8_BAR; PG8_SCHED;
            PG8_LDB(B0, 1, 0); PG8_LDB(B1, 1, 1); PG8_SCHED; PG8_LDA(At, 1, 0); PG8_STAGE(PG8_SA(0, 1), a2 + hstep, voffA);
            PG8_WAIT_V(8); PG8_WAIT_L(0); PG8_BAR; PG8_MMA(0, 0, At, B0); PG8_MMA(0, 1, At, B1); PG8_BAR; PG8_SCHED;
            PG8_LDA(At, 1, 1); PG8_STAGE(PG8_SB(1, 0), b3, voffB); PG8_STAGE(PG8_SB(1, 1), b3 + hstep, voffB); PG8_STAGE(PG8_SA(1, 0), a3, voffA);
            PG8_WAIT_V(8); PG8_WAIT_L(0); PG8_BAR; PG8_MMA(1, 0, At, B0); PG8_MMA(1, 1, At, B1); PG8_BAR; PG8_SCHED;
            } else {
            PG8_LDB(B0, 0, 0); PG8_SCHED; PG8_LDA(At, 0, 0); PG8_STAGE(PG8_SA(1, 1), a1 + hstep, voffA);
            PG8_WAIT_L(8); PG8_BAR; PG8_WAIT_L(0); PG8_MMA(0, 0, At, B0); PG8_BAR; PG8_SCHED;
            PG8_LDB(B1, 0, 1); PG8_STAGE(PG8_SB(0, 0), b2, voffB);
            PG8_BAR; PG8_WAIT_L(0); PG8_MMA(0, 1, At, B1); PG8_BAR;
            PG8_LDA(At, 0, 1); PG8_STAGE(PG8_SA(0, 0), a2, voffA);
            PG8_BAR; PG8_WAIT_L(0); PG8_MMA(1, 0, At, B0); PG8_BAR; PG8_SCHED;
            PG8_STAGE(PG8_SB(0, 1), b2 + hstep, voffB);
            PG8_WAIT_V(6); PG8_BAR; PG8_MMA(1, 1, At, B1); PG8_BAR;
            PG8_LDB(B0, 1, 0); PG8_SCHED; PG8_LDA(At, 1, 0); PG8_STAGE(PG8_SA(0, 1), a2 + hstep, voffA);
            PG8_WAIT_L(8); PG8_BAR; PG8_WAIT_L(0); PG8_MMA(0, 0, At, B0); PG8_BAR; PG8_SCHED;
            PG8_LDB(B1, 1, 1); PG8_STAGE(PG8_SB(1, 0), b3, voffB);
            PG8_BAR; PG8_WAIT_L(0); PG8_MMA(0, 1, At, B1); PG8_BAR;
            PG8_LDA(At, 1, 1); PG8_STAGE(PG8_SA(1, 0), a3, voffA);
            PG8_BAR; PG8_WAIT_L(0); PG8_MMA(1, 0, At, B0); PG8_BAR; PG8_SCHED;
            PG8_STAGE(PG8_SB(1, 1), b3 + hstep, voffB);
            PG8_WAIT_V(6); PG8_BAR; PG8_MMA(1, 1, At, B1); PG8_BAR;
            }
        }
        if constexpr (ALIGN_EPI) { if (wr == 0) PG8_BAR; }
        if constexpr (!Epi::AFTER_DRAIN) { E(acc, cur, wr, wc, fr, fq); S.done(cur); }
        if (!has_next) break;
#pragma unroll
        for (int a = 0; a < 2; ++a)
#pragma unroll
            for (int b = 0; b < 2; ++b)
#pragma unroll
                for (int m = 0; m < 4; ++m)
#pragma unroll
                    for (int n = 0; n < 2; ++n) acc[a][b][m][n] = (f32x4){0.f, 0.f, 0.f, 0.f};
        cur = nxt; cA = nA; cB = nB; ++ui;
        if constexpr (ALIGN_EPI) { if (wr == 1) PG8_BAR; }
    }
    PG8_WAIT_V(0);
    if constexpr (!ALIGN_EPI) { if (wr == 0) PG8_BAR; }
    PG8_BAR;
    if constexpr (Epi::AFTER_DRAIN) { E.fused(acc, cur, wr, wc, fr, fq, lds, wid, lane); S.done(cur); }
#undef PG8_SA
#undef PG8_SB
#undef PG8_STAGE
#undef PG8_LDA
#undef PG8_LDB
#undef PG8_MMA
#undef PG8_WAIT_V
#undef PG8_WAIT_L
#undef PG8_BAR
#undef PG8_SCHED
}
}

#define LAS __attribute__((address_space(3)))
typedef unsigned short bf16;
typedef float f32x4 __attribute__((ext_vector_type(4)));
typedef short bf16x8 __attribute__((ext_vector_type(8)));
typedef short s16x4 __attribute__((ext_vector_type(4)));
typedef unsigned u32x4 __attribute__((ext_vector_type(4)));
typedef unsigned u32x2 __attribute__((ext_vector_type(2)));

constexpr int NWAVES = 8, NT = 512;
constexpr int SEQ = 2048, M = 16384, D = 2048, NL = 2;
constexpr int P = 5656, PP = 5888, FF = 5632, NGU = 11264;
constexpr int GQ = 0, GK = 384, GV = 768, GG = 1536, MQ = 2304, MK = 2688, MV = 3072, MO = 3840, SU = 4608, SV = 5120, GA1 = 5632, MI = 5648, MF = 5652;
constexpr float EPS = 1e-6f;
constexpr float QK_SCALE = 0.10206207261596577f;
constexpr size_t MiB = 1u << 20;
constexpr size_t WS_LAYER = 97 * MiB, WS_WIN = 0, WS_WOUT = 23 * MiB, WS_WGU = 31 * MiB, WS_WDN = 75 * MiB;
constexpr size_t WS_XN = 194 * MiB, WS_PROJ = 258 * MiB, WS_MIX = 442 * MiB, WS_QG = 506 * MiB, WS_KG = 518 * MiB, WS_QM = 530 * MiB, WS_KM = 542 * MiB;
constexpr size_t WS_ELAST = 554 * MiB, WS_CUMF = 555 * MiB, WS_PMX = 556 * MiB, WS_CTL = 557 * MiB, WS_SSQ = 558 * MiB, WS_END = 559 * MiB;
constexpr size_t CTL_BYTES = 16384;

constexpr int LDS_BYTES = 147456;
constexpr int LDS_CTL_OFF = LDS_BYTES - 64;

struct Ctx {
    const float *x, *norm_mix, *w_in, *gla_a2, *gla_ab, *gla_norm, *ml_conv, *ml_ib, *ml_fb, *ml_norm, *sgu_ln_g, *sgu_ln_b, *sgu_w, *sgu_b, *w_out, *norm_ffn, *w_gu, *w_down, *norm_final;
    float* out; unsigned char* ws;
    bf16 *xn, *proj, *act, *mix, *qg, *kg, *qm, *km; float *elast, *cumf, *pmx;
};

__device__ __forceinline__ float bf2f(unsigned v) { return __uint_as_float(v << 16); }
__device__ __forceinline__ unsigned f2bf(float f) { unsigned u = __float_as_uint(f); return (u + 0x7fffu + ((u >> 16) & 1u)) >> 16; }
__device__ __forceinline__ unsigned pk2(float lo, float hi) { return pg8::cvt_pk_bf16(lo, hi); }
__device__ __forceinline__ float lo16(unsigned w) { return __uint_as_float(w << 16); }
__device__ __forceinline__ float hi16(unsigned w) { return __uint_as_float(w & 0xffff0000u); }
__device__ __forceinline__ float wave_sum(float v) {
#pragma unroll
    for (int o = 1; o < 64; o <<= 1) v += __shfl_xor(v, o);
    return v;
}
__device__ __forceinline__ float logsig(float z) { return fminf(z, 0.f) - log1pf(__expf(-fabsf(z))); }
__device__ __forceinline__ float logsig_fast(float z) { return fminf(z, 0.f) - __logf(1.0f + __expf(-fabsf(z))); }
__device__ __forceinline__ float sigmoidf_(float z) { return __builtin_amdgcn_rcpf(1.0f + __expf(-z)); }
__device__ __forceinline__ float gelu_tanh(float x) { const float u = 0.7978845608028654f * (x + 0.044715f * x * x * x); return x * sigmoidf_(2.0f * u); }
__device__ __forceinline__ s16x4 vtr(const LAS unsigned char* p) { typedef short v4i16_t __attribute__((ext_vector_type(4))); return __builtin_bit_cast(s16x4, __builtin_amdgcn_ds_read_tr16_b64_v4i16((LAS v4i16_t*)p)); }
__device__ __forceinline__ bf16x8 vtr2(const LAS unsigned char* p, int step) { const s16x4 lo = vtr(p), hi = vtr(p + step); return __builtin_shufflevector(lo, hi, 0, 1, 2, 3, 4, 5, 6, 7); }
__device__ __forceinline__ bf16x8 ld128(const LAS unsigned char* p) { return *(const LAS bf16x8*)p; }
#define WG_BAR() do { asm volatile("s_waitcnt lgkmcnt(0)" ::: "memory"); __builtin_amdgcn_s_barrier(); asm volatile("" ::: "memory"); } while (0)
#define MFMA16(a, b, c) __builtin_amdgcn_mfma_f32_16x16x32_bf16((a), (b), (c), 0, 0, 0)

constexpr int I_IN = 32 * (PP / 32), I_OUT = 32 * (D / 32), I_GU = 32 * (NGU / 32), I_DN = (FF / 64) * (D / 32), I_L = I_IN + I_OUT + I_GU + I_DN;
template <bool REMAP> __device__ __forceinline__ void transpose_item(const float* W, int K, int N, bf16* WT, int dst_row0, int k0, int n0, LAS float* scr, int lane, const float* gk) {
    int n = n0 + (lane & 31); bool ok = n < N;
    if (REMAP) { const int d = n;
        n = d < 2304 ? d : d < 4608 ? d + 16 : d < 5632 ? d + 24 : d < 5648 ? d - 5632 + 2304 : d < 5656 ? d - 5648 + 4624 : 0; ok = d < 5656; }
    float wv_[32];
#pragma unroll
    for (int i = 0; i < 32; ++i) { const int kk = 2 * i + (lane >> 5); wv_[i] = ok ? W[(size_t)(k0 + kk) * N + n] : 0.f; }
#pragma unroll
    for (int i = 0; i < 32; ++i) { const int kk = 2 * i + (lane >> 5); scr[kk * 33 + (lane & 31)] = wv_[i]; }
    asm volatile("s_waitcnt lgkmcnt(0)" ::: "memory");
    const int c = lane & 7;
    f32x4 g0 = (f32x4){1.f, 1.f, 1.f, 1.f}, g1 = g0;
    if (gk) { g0 = *(const f32x4*)(gk + k0 + 8 * c); g1 = *(const f32x4*)(gk + k0 + 8 * c + 4); }
#pragma unroll
    for (int j = 0; j < 4; ++j) { const int nn = (lane >> 3) + 8 * j; const LAS float* s = scr + (8 * c) * 33 + nn;
        u32x4 o; o.x = pk2(s[0 * 33] * g0.x, s[1 * 33] * g0.y); o.y = pk2(s[2 * 33] * g0.z, s[3 * 33] * g0.w); o.z = pk2(s[4 * 33] * g1.x, s[5 * 33] * g1.y); o.w = pk2(s[6 * 33] * g1.z, s[7 * 33] * g1.w);
        *(u32x4*)(WT + (size_t)(dst_row0 + nn) * K + k0 + 8 * c) = o; }
    asm volatile("s_waitcnt lgkmcnt(0)" ::: "memory");
}
__device__ __forceinline__ void convert_weights(const Ctx& X, LAS unsigned char* lds, int gwb, int ngw, int it_lo, int it_hi) {
    int tid_ = threadIdx.x; asm volatile("" : "+v"(tid_)); const int lane = tid_ & 63, wave = __builtin_amdgcn_readfirstlane(tid_ >> 6), gw = gwb + wave;
    LAS float* scr = (LAS float*)(lds + wave * 16384);
    for (int it = it_lo + gw; it < it_hi; it += ngw) {
        const int l = it / I_L; int r = it - l * I_L; unsigned char* wl = X.ws + (size_t)l * WS_LAYER;
        if (r < I_IN) { const int nb = PP / 32, kb = r / nb, n0 = 32 * (r % nb); transpose_item<true>(X.w_in + (size_t)l * D * P, D, P, (bf16*)(wl + WS_WIN), n0, 64 * kb, n0, scr, lane, X.norm_mix + l * D); continue; } r -= I_IN;
        if (r < I_OUT) { const int nb = D / 32, kb = r / nb, n0 = 32 * (r % nb); transpose_item<false>(X.w_out + (size_t)l * D * D, D, D, (bf16*)(wl + WS_WOUT), n0, 64 * kb, n0, scr, lane, nullptr); continue; } r -= I_OUT;
        if (r < I_GU) { const int nb = NGU / 32, kb = r / nb, n0 = 32 * (r % nb); const int up = n0 >= FF, nn = n0 - up * FF, dr = 256 * (nn / 128) + 128 * up + (nn % 128);
            transpose_item<false>(X.w_gu + (size_t)l * D * NGU, D, NGU, (bf16*)(wl + WS_WGU), dr, 64 * kb, n0, scr, lane, X.norm_ffn + l * D); continue; } r -= I_GU;
        { const int nb = D / 32, kb = r / nb, n0 = 32 * (r % nb); transpose_item<false>(X.w_down + (size_t)l * FF * D, FF, D, (bf16*)(wl + WS_WDN), n0, 64 * kb, n0, scr, lane, nullptr); }
    }
}
__device__ __forceinline__ void rows_bf16_ssq(const float* x, bf16* ob, unsigned long long* ssq, int gwb, int ngw) {
    int tid_ = threadIdx.x; asm volatile("" : "+v"(tid_)); const int lane = tid_ & 63, gw = gwb + __builtin_amdgcn_readfirstlane(tid_ >> 6);
    for (int m = gw; m < M; m += ngw) {
        const f32x4* xr = (const f32x4*)(x + (size_t)m * D) + lane; f32x4 v[8]; float s = 0.f;
#pragma unroll
        for (int j = 0; j < 8; ++j) { v[j] = xr[64 * j]; s += (v[j].x * v[j].x + v[j].y * v[j].y) + (v[j].z * v[j].z + v[j].w * v[j].w); }
        s = wave_sum(s);
#pragma unroll
        for (int j = 0; j < 8; ++j) { u32x2 w; w.x = pk2(v[j].x, v[j].y); w.y = pk2(v[j].z, v[j].w); *((u32x2*)(ob + (size_t)m * D) + lane + 64 * j) = w; }
        if (lane == 0) ssq[m] = (unsigned long long)(s * 1048576.0f + 0.5f);
    }
}
__device__ __forceinline__ void rows_final_norm(const bf16* xb, float* out, const float* g, const unsigned long long* ssq, int gwb, int ngw, int nrows) {
    int tid_ = threadIdx.x; asm volatile("" : "+v"(tid_)); const int lane = tid_ & 63, gw = gwb + __builtin_amdgcn_readfirstlane(tid_ >> 6);
    f32x4 gv[8];
#pragma unroll
    for (int j = 0; j < 8; ++j) gv[j] = *((const f32x4*)g + lane + 64 * j);
    for (int m = gw; m < nrows; m += ngw) {
        const u32x2* xr = (const u32x2*)(xb + (size_t)m * D) + lane; f32x4* orow = (f32x4*)(out + (size_t)m * D) + lane; const float rstd = 1.0f / sqrtf((float)ssq[m] * (1.0f / 1048576.0f) * (1.0f / D) + EPS);
        u32x2 w[8];
#pragma unroll
        for (int j = 0; j < 8; ++j) w[j] = xr[64 * j];
#pragma unroll
        for (int j = 0; j < 8; ++j) { const f32x4 v = (f32x4){lo16(w[j].x), hi16(w[j].x), lo16(w[j].y), hi16(w[j].y)}; __builtin_nontemporal_store(v * rstd * gv[j], orow + 64 * j); }
    }
}

__device__ __forceinline__ void prepass_item(const Ctx& X, int l, int item, LAS unsigned char* lds) {
    int tid_ = threadIdx.x; asm volatile("" : "+v"(tid_)); const int tid = tid_, lane = tid & 63, wid = tid >> 6;
    const int b = item >> 5, c = item & 31; const size_t row0 = (size_t)b * SEQ + c * 64;
    LAS float* ga = (LAS float*)lds;
    LAS float* ea = (LAS float*)(lds + 4096);
    constexpr int TOFF = 8192, RP = 1552;
    const bf16* proj = X.proj;
    u32x4 ta[12], tb[13];
#pragma unroll
    for (int j = 0; j < 12; ++j) { const int p = tid + 512 * j, row = p / 96, pc = p % 96; ta[j] = *(const u32x4*)(proj + (row0 + row) * PP + GQ + pc * 8); }
#pragma unroll
    for (int j = 0; j < 13; ++j) { const int p = tid + 512 * j, row = p / 96, pc = p % 96; tb[j] = (u32x4){0u, 0u, 0u, 0u};
        if (p < 67 * 96 && (c > 0 || row >= 3)) tb[j] = *(const u32x4*)(proj + (row0 + row - 3) * PP + MQ + pc * 8); }
    if (wid < 4) {
        const int h = wid; const size_t r = row0 + lane;
        const float ip = bf2f(proj[r * PP + MI + h]) + X.ml_ib[l * 4 + h];
        const float lf = logsig(bf2f(proj[r * PP + MF + h]) + X.ml_fb[l * 4 + h]);
        float cum = lf;
#pragma unroll
        for (int o = 1; o < 64; o <<= 1) { const float v = __shfl_up(cum, o); if (lane >= o) cum += v; }
        const float a = ip - cum; float pm = a;
#pragma unroll
        for (int o = 1; o < 64; o <<= 1) { const float v = __shfl_up(pm, o); if (lane >= o) pm = fmaxf(pm, v); }
        X.cumf[r * 4 + h] = cum; X.pmx[r * 4 + h] = pm; ea[lane * 4 + h] = __expf(a);
    } else {
        const int i = tid - 256;
#pragma unroll
        for (int k = 0; k < 4; ++k) { const int e = i + 256 * k, t = e >> 4, rr = e & 15; ga[e] = bf2f(proj[(row0 + t) * PP + GA1 + rr]); }
    }
#pragma unroll
    for (int j = 0; j < 12; ++j) { const int p = tid + 512 * j, row = p / 96, pc = p % 96; *(LAS u32x4*)(lds + TOFF + row * RP + pc * 16) = ta[j]; }
    __syncthreads();
    if (tid < 384) {
        const int col = tid; float a2r[16];
#pragma unroll
        for (int r = 0; r < 16; ++r) a2r[r] = X.gla_a2[(size_t)(l * 16 + r) * 384 + col];
        const float ab = X.gla_ab[l * 384 + col]; float cum = 0.f;
        LAS unsigned short* qc = (LAS unsigned short*)(lds + TOFF + col * 2); LAS unsigned short* kc = (LAS unsigned short*)(lds + TOFF + (384 + col) * 2);
#pragma unroll 4
        for (int t = 0; t < 64; ++t) {
            float z = ab;
#pragma unroll
            for (int r = 0; r < 16; ++r) z += ga[t * 16 + r] * a2r[r];
            cum += logsig_fast(z) * (1.0f / 16.0f);
            const float e = __expf(cum), ei = __expf(-cum);
            const float q = bf2f(qc[t * (RP / 2)]), kk = bf2f(kc[t * (RP / 2)]);
            qc[t * (RP / 2)] = (unsigned short)f2bf(q * e * QK_SCALE); kc[t * (RP / 2)] = (unsigned short)f2bf(kk * ei);
        }
        X.elast[(size_t)(b * 32 + c) * 384 + col] = __expf(cum);
    }
    __syncthreads();
#pragma unroll
    for (int j = 0; j < 12; ++j) { const int p = tid + 512 * j, row = p / 96, pc = p % 96; const u32x4 v = *(const LAS u32x4*)(lds + TOFF + row * RP + pc * 16);
        bf16* dstp = (pc >= 48 ? X.kg : X.qg) + (row0 + row) * 384 + (pc % 48) * 8; *(u32x4*)dstp = v; }
    __syncthreads();
#pragma unroll
    for (int j = 0; j < 13; ++j) { const int p = tid + 512 * j, row = p / 96, pc = p % 96; if (p < 67 * 96) *(LAS u32x4*)(lds + TOFF + row * RP + pc * 16) = tb[j]; }
    __syncthreads();
    for (int cc = tid; cc < 768; cc += NT) {
        const float w0 = X.ml_conv[(size_t)(l * 4 + 0) * 768 + cc], w1 = X.ml_conv[(size_t)(l * 4 + 1) * 768 + cc], w2 = X.ml_conv[(size_t)(l * 4 + 2) * 768 + cc], w3 = X.ml_conv[(size_t)(l * 4 + 3) * 768 + cc];
        LAS unsigned short* xc_ = (LAS unsigned short*)(lds + TOFF + cc * 2);
        float x3 = bf2f(xc_[0]), x2 = bf2f(xc_[RP / 2]), x1 = bf2f(xc_[2 * (RP / 2)]);
        const bool isk = cc >= 384; const int hh = isk ? (cc - 384) / 96 : 0;
#pragma unroll 4
        for (int t = 0; t < 64; ++t) {
            const float xc = bf2f(xc_[(t + 3) * (RP / 2)]);
            const float y = w0 * x3 + w1 * x2 + w2 * x1 + w3 * xc; float s = y * sigmoidf_(y);
            if (isk) s *= QK_SCALE * ea[t * 4 + hh];
            xc_[(t + 3) * (RP / 2)] = (unsigned short)f2bf(s); x3 = x2; x2 = x1; x1 = xc;
        }
    }
    __syncthreads();
#pragma unroll
    for (int j = 0; j < 12; ++j) { const int p = tid + 512 * j, row = p / 96, pc = p % 96; const u32x4 v = *(const LAS u32x4*)(lds + TOFF + (row + 3) * RP + pc * 16);
        bf16* dstp = (pc >= 48 ? X.km : X.qm) + (row0 + row) * 384 + (pc % 48) * 8; *(u32x4*)dstp = v; }
    __syncthreads();
}

constexpr int SC_QS = 0, SC_KS = 13312, SC_VS = 26624, SC_PS = 54272, SC_ST = 63488, SC_RED = 106752, SC_DEN = 107776, SC_GT = 108032, SC_GN = 108544;
constexpr int QP = 208, VP = 432, PPI = 144, STP = 208;
template <bool ML> __device__ __forceinline__ void scan_item(const Ctx& X, int l, int b, int h, LAS unsigned char* lds) {
    int tid_ = threadIdx.x; asm volatile("" : "+v"(tid_)); const int tid = tid_, lane = tid & 63, wid = __builtin_amdgcn_readfirstlane(tid >> 6);
    const int wh = wid >> 2, wq = wid & 3;
#define LANEV int ln_ = lane; asm volatile("" : "+v"(ln_)); const int r = ln_ & 15, g = ln_ >> 4, q4 = (ln_ & 15) >> 2, p4 = ln_ & 3; (void)r; (void)g; (void)q4; (void)p4;
    const bool v4 = ML && (wq == 3);
    const bf16* qsrc = (ML ? X.qm : X.qg) + h * 96; const bf16* ksrc = (ML ? X.km : X.kg) + h * 96;
    const bf16* vsrc = X.proj + (ML ? MV : GV) + h * 192; const bf16* gsrc = X.proj + (ML ? MO : GG) + h * 192;
    bf16* dst = X.mix + (ML ? 768 : 0) + h * 192;
    const size_t rowb = (size_t)b * SEQ;
    unsigned z_ = 0u, one_ = ML ? 0x00003F80u : 0u; asm volatile("" : "+v"(z_), "+v"(one_));
    for (int i = tid; i < (208 * STP) / 16; i += NT) *(LAS u32x4*)(lds + SC_ST + i * 16) = (u32x4){z_, z_, z_, z_};
    if (tid < 64) { LAS unsigned* vp = (LAS unsigned*)(lds + SC_VS + tid * VP + 384);
#pragma unroll
        for (int i = 0; i < 8; ++i) vp[i] = (i == 0) ? one_ : z_; }
#define STG_OFFS int t_ = tid; asm volatile("" : "+v"(t_)); const int qr_ = t_ >> 4, qc_ = t_ & 15, vr_ = t_ >> 5, vc_ = t_ & 31; const bool qok_ = qc_ < 12, vok_ = vc_ < 24; \
        const unsigned qoff = (unsigned)(qr_ * 384 + qc_ * 8), qlds = (unsigned)(qr_ * QP + qc_ * 16), voff = (unsigned)(vr_ * PP + vc_ * 8), vlds = (unsigned)(vr_ * VP + vc_ * 16); \
        (void)qoff; (void)qlds; (void)voff; (void)vlds; (void)qok_; (void)vok_;
    u32x4 sq[2], sk[2], sv[4]; f32x4 sg = (f32x4){0.f, 0.f, 0.f, 0.f};
#pragma unroll
    for (int p = 0; p < 2; ++p) { sq[p] = (u32x4){0u, 0u, 0u, 0u}; sk[p] = sq[p]; }
#pragma unroll
    for (int p = 0; p < 4; ++p) sv[p] = (u32x4){0u, 0u, 0u, 0u};
#define SC_LOAD(c_) do { STG_OFFS const size_t rb_ = rowb + (size_t)(c_) * 64; const bf16* qb_ = qsrc + rb_ * 384; const bf16* kb_ = ksrc + rb_ * 384; const bf16* vb_ = vsrc + rb_ * PP; \
        if (qok_) { _Pragma("unroll") for (int p = 0; p < 2; ++p) { sq[p] = *(const u32x4*)(qb_ + qoff + p * (32 * 384)); sk[p] = *(const u32x4*)(kb_ + qoff + p * (32 * 384)); } } \
        if (vok_) { _Pragma("unroll") for (int p = 0; p < 4; ++p) sv[p] = *(const u32x4*)(vb_ + voff + p * (16 * PP)); } \
        if (ML) { if (tid < 64) { sg.x = X.pmx[(rb_ + tid) * 4 + h]; sg.y = X.cumf[(rb_ + tid) * 4 + h]; } } \
        else { if (tid < 24) sg = *(const f32x4*)(X.elast + (size_t)(b * 32 + (c_)) * 384 + h * 96 + 4 * tid); } } while (0)
#define SC_STORE() do { STG_OFFS \
        if (qok_) { _Pragma("unroll") for (int p = 0; p < 2; ++p) { *(LAS u32x4*)(lds + SC_QS + qlds + p * (32 * QP)) = sq[p]; *(LAS u32x4*)(lds + SC_KS + qlds + p * (32 * QP)) = sk[p]; } } \
        if (vok_) { _Pragma("unroll") for (int p = 0; p < 4; ++p) *(LAS u32x4*)(lds + SC_VS + vlds + p * (16 * VP)) = sv[p]; } \
        if (ML) { if (tid < 64) { *(LAS float*)(lds + SC_GT + tid * 4) = sg.x; *(LAS float*)(lds + SC_GT + 256 + tid * 4) = sg.y; } } \
        else { if (tid < 24) *(LAS f32x4*)(lds + SC_GT + tid * 16) = sg; } } while (0)
#define GT_PM(t_) (*(const LAS float*)(lds + SC_GT + (t_) * 4))
#define GT_CUM(t_) (*(const LAS float*)(lds + SC_GT + 256 + (t_) * 4))
    SC_LOAD(0); SC_STORE();
    f32x4 sacc[3][4];
#pragma unroll
    for (int i = 0; i < 3; ++i)
#pragma unroll
        for (int j = 0; j < 4; ++j) sacc[i][j] = (f32x4){0.f, 0.f, 0.f, 0.f};
    float m_st = 0.f;
    const int tb1 = wid >> 1;
    __syncthreads();
    for (int c = 0; c < 32; ++c) {
        const size_t rbc = rowb + (size_t)c * 64;
        if (c + 1 < 32) { SC_LOAD(c + 1); }
        float pm63 = 0.f, cum63 = 0.f, pmt[2] = {0.f, 0.f}, cumt[2] = {0.f, 0.f};
        if (ML) { LANEV pm63 = GT_PM(63); cum63 = GT_CUM(63);
#pragma unroll
            for (int ti = 0; ti < 2; ++ti) { pmt[ti] = GT_PM(16 * (2 * wh + ti) + r); cumt[ti] = GT_CUM(16 * (2 * wh + ti) + r); } }
        u32x2 gate[2][3];
        { LANEV const bf16* gb_ = gsrc + rbc * PP;
#pragma unroll
        for (int ti = 0; ti < 2; ++ti)
#pragma unroll
            for (int vi = 0; vi < 3; ++vi) gate[ti][vi] = *(const u32x2*)(gb_ + (unsigned)((16 * (2 * wh + ti) + r) * PP + 16 * (3 * wq + vi) + 4 * g)); }
        {
            LANEV bf16x8 qf[3], kf[2][3];
#pragma unroll
            for (int ds = 0; ds < 3; ++ds) qf[ds] = ld128(lds + SC_QS + (16 * tb1 + r) * QP + (32 * ds + 8 * g) * 2);
#pragma unroll
            for (int si = 0; si < 2; ++si)
#pragma unroll
                for (int ds = 0; ds < 3; ++ds) kf[si][ds] = ld128(lds + SC_KS + (16 * (2 * (wid & 1) + si) + r) * QP + (32 * ds + 8 * g) * 2);
            __builtin_amdgcn_sched_barrier(0);
#pragma unroll
            for (int si = 0; si < 2; ++si) {
                const int sb = 2 * (wid & 1) + si; f32x4 acc = (f32x4){0.f, 0.f, 0.f, 0.f};
                if (sb <= tb1) {
#pragma unroll
                    for (int ds = 0; ds < 3; ++ds) acc = MFMA16(kf[si][ds], qf[ds], acc);
#pragma unroll
                    for (int j = 0; j < 4; ++j) { const bool keep = (16 * sb + 4 * g + j) <= (16 * tb1 + r); acc[j] = keep ? acc[j] : 0.f; }
                }
                u32x2 w; w.x = pk2(acc[0], acc[1]); w.y = pk2(acc[2], acc[3]);
                *(LAS u32x2*)(lds + SC_PS + (16 * tb1 + r) * PPI + (16 * sb + 4 * g) * 2) = w;
            }
        }
        f32x4 oacc[2][4];
#pragma unroll
        for (int ti = 0; ti < 2; ++ti)
#pragma unroll
            for (int vi = 0; vi < 4; ++vi) oacc[ti][vi] = (f32x4){0.f, 0.f, 0.f, 0.f};
        {
            LANEV bf16x8 qf[2][3];
#pragma unroll
            for (int ti = 0; ti < 2; ++ti)
#pragma unroll
                for (int ds = 0; ds < 3; ++ds) qf[ti][ds] = ld128(lds + SC_QS + (16 * (2 * wh + ti) + r) * QP + (32 * ds + 8 * g) * 2);
#pragma unroll
            for (int vh = 0; vh < 2; ++vh) {
                bf16x8 sf[2][3];
#pragma unroll
                for (int v2 = 0; v2 < 2; ++v2)
#pragma unroll
                    for (int ds = 0; ds < 3; ++ds) { const int vi = 2 * vh + v2;
                        if (vi < 3 || v4) sf[v2][ds] = ld128(lds + SC_ST + (16 * (3 * wq + vi) + r) * STP + (32 * ds + 8 * g) * 2); else sf[v2][ds] = (bf16x8){0, 0, 0, 0, 0, 0, 0, 0}; }
                __builtin_amdgcn_sched_barrier(0);
#pragma unroll
                for (int v2 = 0; v2 < 2; ++v2) { const int vi = 2 * vh + v2;
                    if (vi < 3 || v4) {
#pragma unroll
                        for (int ds = 0; ds < 3; ++ds)
#pragma unroll
                            for (int ti = 0; ti < 2; ++ti) oacc[ti][vi] = MFMA16(sf[v2][ds], qf[ti][ds], oacc[ti][vi]);
                    } }
                __builtin_amdgcn_sched_barrier(0);
            }
        }
        WG_BAR();
        bf16x8 vf[4][2];
        { LANEV
#pragma unroll
        for (int vi = 0; vi < 4; ++vi)
#pragma unroll
            for (int ss = 0; ss < 2; ++ss)
                if (vi < 3 || v4) vf[vi][ss] = vtr2(lds + SC_VS + (32 * ss + 8 * g + q4) * VP + (16 * (3 * wq + vi) + 4 * p4) * 2, 4 * VP);
                else vf[vi][ss] = (bf16x8){0, 0, 0, 0, 0, 0, 0, 0};
        }
        {
            LANEV bf16x8 pf[2][2];
#pragma unroll
            for (int ti = 0; ti < 2; ++ti)
#pragma unroll
                for (int ss = 0; ss < 2; ++ss) pf[ti][ss] = ld128(lds + SC_PS + (16 * (2 * wh + ti) + r) * PPI + (32 * ss + 8 * g) * 2);
            __builtin_amdgcn_sched_barrier(0);
#pragma unroll
            for (int vi = 0; vi < 4; ++vi)
                if (vi < 3 || v4) {
#pragma unroll
                    for (int ti = 0; ti < 2; ++ti)
#pragma unroll
                        for (int ss = 0; ss < 2; ++ss) oacc[ti][vi] = MFMA16(vf[vi][ss], pf[ti][ss], oacc[ti][vi]);
                }
        }
        { LANEV
#pragma unroll
        for (int ti = 0; ti < 2; ++ti) {
            float s = 0.f;
#pragma unroll
            for (int vi = 0; vi < 3; ++vi)
#pragma unroll
                for (int j = 0; j < 4; ++j) s += oacc[ti][vi][j] * oacc[ti][vi][j];
            s += __shfl_xor(s, 16); s += __shfl_xor(s, 32);
            if (g == 0) { *(LAS float*)(lds + SC_RED + ((16 * (2 * wh + ti) + r) * 4 + wq) * 4) = s; if (v4) *(LAS float*)(lds + SC_DEN + (16 * (2 * wh + ti) + r) * 4) = oacc[ti][3][0]; }
        } }
        u32x2 opk[2][3];
#pragma unroll
        for (int ti = 0; ti < 2; ++ti)
#pragma unroll
            for (int vi = 0; vi < 3; ++vi) { opk[ti][vi].x = pk2(oacc[ti][vi][0], oacc[ti][vi][1]); opk[ti][vi].y = pk2(oacc[ti][vi][2], oacc[ti][vi][3]); }
        {
            LANEV const float e_out = ML ? __expf(cum63) : 1.0f;
            bf16x8 kt[3][2];
#pragma unroll
            for (int di = 0; di < 3; ++di)
#pragma unroll
                for (int ss = 0; ss < 2; ++ss) kt[di][ss] = vtr2(lds + SC_KS + (32 * ss + 8 * g + q4) * QP + (16 * (3 * wh + di) + 4 * p4) * 2, 4 * QP);
            __builtin_amdgcn_sched_barrier(0);
#pragma unroll
            for (int di = 0; di < 3; ++di)
#pragma unroll
                for (int vi = 0; vi < 4; ++vi)
                    if (vi < 3 || v4) {
#pragma unroll
                        for (int ss = 0; ss < 2; ++ss) sacc[di][vi] = MFMA16(kt[di][ss], vf[vi][ss], sacc[di][vi]);
                    }
            __builtin_amdgcn_sched_barrier(0);
#pragma unroll
            for (int di = 0; di < 3; ++di) {
                f32x4 dec = (f32x4){e_out, e_out, e_out, e_out};
                if (!ML) dec = *(const LAS f32x4*)(lds + SC_GT + (16 * (3 * wh + di) + 4 * g) * 4);
#pragma unroll
                for (int vi = 0; vi < 4; ++vi)
                    if (vi < 3 || v4) {
                        const f32x4 a = sacc[di][vi] * dec; sacc[di][vi] = a;
                        u32x2 w; w.x = pk2(a[0], a[1]); w.y = pk2(a[2], a[3]);
                        *(LAS u32x2*)(lds + SC_ST + (16 * (3 * wq + vi) + r) * STP + (16 * (3 * wh + di) + 4 * g) * 2) = w;
                    }
            }
        }
        WG_BAR();
        { LANEV
#pragma unroll
        for (int ti = 0; ti < 2; ++ti) {
            const int t = 16 * (2 * wh + ti) + r;
            const f32x4 rp = *(const LAS f32x4*)(lds + SC_RED + t * 16);
            float ssq = (rp.x + rp.y) + (rp.z + rp.w), inv = 1.0f;
            if (ML) { const float Mt = fmaxf(m_st, pmt[ti]), eM = __expf(-Mt); const float den = *(const LAS float*)(lds + SC_DEN + t * 4) * eM;
                const float dn = fmaxf(fabsf(den), __expf(-(cumt[ti] + Mt))); inv = eM / dn; ssq = ssq * inv * inv; }
            const float rstd = inv / sqrtf(ssq * (1.0f / 192.0f) + EPS);
#pragma unroll
            for (int vi = 0; vi < 3; ++vi) {
                const int dv = 16 * (3 * wq + vi) + 4 * g;
                const float a0 = lo16(gate[ti][vi].x) * rstd, a1 = hi16(gate[ti][vi].x) * rstd, a2 = lo16(gate[ti][vi].y) * rstd, a3 = hi16(gate[ti][vi].y) * rstd;
                const f32x4 o = (f32x4){lo16(opk[ti][vi].x), hi16(opk[ti][vi].x), lo16(opk[ti][vi].y), hi16(opk[ti][vi].y)};
                u32x2 w; w.x = pk2(o[0] * a0, o[1] * a1); w.y = pk2(o[2] * a2, o[3] * a3);
                *(u32x2*)(dst + rbc * D + (unsigned)(t * D + dv)) = w;
            }
        } }
        if (ML) m_st = cum63 + fmaxf(m_st, pm63);
        if (c + 1 < 32) SC_STORE();
        WG_BAR();
    }
#undef SC_LOAD
#undef SC_STORE
#undef LANEV
#undef STG_OFFS
#undef GT_PM
#undef GT_CUM
}

constexpr int SG_W = 0, SG_V = 34816, SGP = 272;
__device__ __forceinline__ void sgu_item(const Ctx& X, int l, int item, LAS unsigned char* lds) {
    int tid_ = threadIdx.x; asm volatile("" : "+v"(tid_)); const int tid = tid_, lane = tid & 63, wid = __builtin_amdgcn_readfirstlane(tid >> 6);
    const int r = lane & 15, g = lane >> 4, q4 = (lane & 15) >> 2, p4 = lane & 3;
    const int grp = item & 3, nb = (item >> 2) & 15, b = item >> 6; const size_t row0 = (size_t)b * SEQ + nb * 128;
    u32x4 raw[16];
#pragma unroll
    for (int i = 0; i < 16; ++i) raw[i] = *(const u32x4*)(X.proj + (row0 + wid * 16 + i) * PP + SV + lane * 8);
    float lgv[8], lbv[8];
    { const f32x4 a0 = *(const f32x4*)(X.sgu_ln_g + l * 512 + lane * 8), a1 = *(const f32x4*)(X.sgu_ln_g + l * 512 + lane * 8 + 4), b0 = *(const f32x4*)(X.sgu_ln_b + l * 512 + lane * 8), b1 = *(const f32x4*)(X.sgu_ln_b + l * 512 + lane * 8 + 4);
      lgv[0] = a0.x; lgv[1] = a0.y; lgv[2] = a0.z; lgv[3] = a0.w; lgv[4] = a1.x; lgv[5] = a1.y; lgv[6] = a1.z; lgv[7] = a1.w;
      lbv[0] = b0.x; lbv[1] = b0.y; lbv[2] = b0.z; lbv[3] = b0.w; lbv[4] = b1.x; lbv[5] = b1.y; lbv[6] = b1.z; lbv[7] = b1.w; }
    { const float* wsrc = X.sgu_w + (size_t)(l * 4 + grp) * 16384; f32x4 wv[8];
#pragma unroll
        for (int k = 0; k < 8; ++k) { const int e = tid + 512 * k, t = e >> 5, s0 = (e & 31) * 4; wv[k] = *(const f32x4*)(wsrc + t * 128 + s0); }
#pragma unroll
        for (int k = 0; k < 8; ++k) { const int e = tid + 512 * k, t = e >> 5, s0 = (e & 31) * 4; const f32x4 w = wv[k];
            u32x2 o; o.x = pk2(s0 <= t ? w.x : 0.f, s0 + 1 <= t ? w.y : 0.f); o.y = pk2(s0 + 2 <= t ? w.z : 0.f, s0 + 3 <= t ? w.w : 0.f);
            *(LAS u32x2*)(lds + SG_W + t * SGP + s0 * 2) = o; } }
#pragma unroll
    for (int i = 0; i < 16; ++i) {
        const int s = wid * 16 + i; const u32x4 rw = raw[i];
        float v[8]; v[0] = lo16(rw.x); v[1] = hi16(rw.x); v[2] = lo16(rw.y); v[3] = hi16(rw.y); v[4] = lo16(rw.z); v[5] = hi16(rw.z); v[6] = lo16(rw.w); v[7] = hi16(rw.w);
        float sm = 0.f;
#pragma unroll
        for (int j = 0; j < 8; ++j) sm += v[j];
        const float mu = wave_sum(sm) * (1.0f / 512.0f); float sq = 0.f;
#pragma unroll
        for (int j = 0; j < 8; ++j) { v[j] -= mu; sq += v[j] * v[j]; }
        const float rstd = 1.0f / sqrtf(wave_sum(sq) * (1.0f / 512.0f) + EPS);
        if ((lane >> 4) == grp) { float y[8];
#pragma unroll
            for (int j = 0; j < 8; ++j) y[j] = v[j] * rstd * lgv[j] + lbv[j];
            u32x4 o; o.x = pk2(y[0], y[1]); o.y = pk2(y[2], y[3]); o.z = pk2(y[4], y[5]); o.w = pk2(y[6], y[7]);
            *(LAS u32x4*)(lds + SG_V + s * SGP + (lane & 15) * 16) = o; }
    }
    __syncthreads();
    {
        const int tb = wid; f32x4 acc[8];
        const int t = 16 * tb + r; const float bs = X.sgu_b[(size_t)(l * 4 + grp) * 128 + t];
        u32x2 suv[8];
#pragma unroll
        for (int cb = 0; cb < 8; ++cb) suv[cb] = *(const u32x2*)(X.proj + (row0 + t) * PP + SU + grp * 128 + 16 * cb + 4 * g);
#pragma unroll
        for (int cb = 0; cb < 8; ++cb) acc[cb] = (f32x4){0.f, 0.f, 0.f, 0.f};
#pragma unroll
        for (int ks = 0; ks < 4; ++ks) {
            if (32 * ks <= 16 * tb + 15) {
                const bf16x8 wf = ld128(lds + SG_W + (16 * tb + r) * SGP + (32 * ks + 8 * g) * 2); bf16x8 vfr[8];
#pragma unroll
                for (int cb = 0; cb < 8; ++cb) vfr[cb] = vtr2(lds + SG_V + (32 * ks + 8 * g + q4) * SGP + (16 * cb + 4 * p4) * 2, 4 * SGP);
                __builtin_amdgcn_sched_barrier(0);
#pragma unroll
                for (int cb = 0; cb < 8; ++cb) acc[cb] = MFMA16(vfr[cb], wf, acc[cb]);
                __builtin_amdgcn_sched_barrier(0);
            }
        }
#pragma unroll
        for (int cb = 0; cb < 8; ++cb) { const int ch = grp * 128 + 16 * cb + 4 * g; const u32x2 su = suv[cb];
            const float u0 = lo16(su.x), u1 = hi16(su.x), u2 = lo16(su.y), u3 = hi16(su.y);
            u32x2 w; w.x = pk2(u0 * (acc[cb][0] + bs), u1 * (acc[cb][1] + bs)); w.y = pk2(u2 * (acc[cb][2] + bs), u3 * (acc[cb][3] + bs));
            *(u32x2*)(X.mix + (row0 + t) * D + 1536 + ch) = w; }
    }
    __syncthreads();
}

#define XB_TMO      128
#define XB_XCNT(j)  (256  + 64 * (j))
#define XB_XSUB(j)  (1280 + 64 * (j))
#define XB_XGEN(j)  (2304 + 64 * (j))
#define XB_TOP      3328
#define XB_TOPGEN   3392
#define XCD_BAR_WORDS 3456
#define XB_SPIN_CAP (1u << 18)

__device__ __forceinline__ unsigned xb_ld(unsigned* p)              { return __hip_atomic_load(p, __ATOMIC_RELAXED, __HIP_MEMORY_SCOPE_AGENT); }
__device__ __forceinline__ unsigned xb_add(unsigned* p, unsigned v) { return __hip_atomic_fetch_add(p, v, __ATOMIC_RELAXED, __HIP_MEMORY_SCOPE_AGENT); }
__device__ __forceinline__ unsigned xb_xcc_id() { return (unsigned)__builtin_amdgcn_s_getreg((3 << 11) | 20) & 0xFu; }
#define XB_SPIN(cond, bar) do { unsigned _sp = 0; while (cond) { __builtin_amdgcn_s_sleep(1); \
    if ((++_sp & 255u) == 0u) { if (xb_ld(&(bar)[XB_TMO])) break; if (_sp > XB_SPIN_CAP) { atomicAdd(&(bar)[XB_TMO], 1u); break; } } } } while (0)

struct XcdBarrier {
    unsigned* bar; unsigned x;
    volatile LAS unsigned* st;
};

__device__ __forceinline__ XcdBarrier xcd_barrier_post(unsigned* bar, volatile LAS unsigned* st) {
    XcdBarrier b; b.bar = bar; b.x = xb_xcc_id(); b.st = st;
    if (threadIdx.x == 0) (void)xb_add(&bar[XB_XCNT(b.x)], 1u);
    return b;
}
__device__ __forceinline__ void xcd_barrier_complete(unsigned* bar, unsigned x, unsigned& nloc, unsigned& nx) {
    const unsigned G = gridDim.x * gridDim.y * gridDim.z;
    unsigned sum, cnt, mine, sp = 0u;
    for (;;) {
        sum = 0u; cnt = 0u; mine = 0u;
#pragma unroll
        for (unsigned j = 0; j < 16; ++j) { const unsigned c = xb_ld(&bar[XB_XCNT(j)]); sum += c; cnt += (c > 0u) ? 1u : 0u; mine = (j == x) ? c : mine; }
        if (sum == G) break;
        __builtin_amdgcn_s_sleep(1);
        if ((++sp & 255u) == 0u) { if (xb_ld(&bar[XB_TMO])) break; if (sp > XB_SPIN_CAP) { atomicAdd(&bar[XB_TMO], 1u); break; } }
    }
    nloc = mine > 0u ? mine : 1u; nx = cnt > 0u ? cnt : 1u;
}

__device__ __forceinline__ void xcd_barrier(const XcdBarrier& b, const bool glob = true) {
    asm volatile("s_waitcnt vmcnt(0)" ::: "memory");
    __syncthreads();
    if (threadIdx.x == 0) {
        unsigned* bar = b.bar;
        __builtin_amdgcn_s_waitcnt(0);
        unsigned nloc = b.st[0], nx = b.st[1];
        if (nloc == 0u) { xcd_barrier_complete(bar, b.x, nloc, nx); b.st[0] = nloc; b.st[1] = nx; }
        const unsigned old = xb_add(&bar[XB_XSUB(b.x)], 1u);
        const unsigned gen = old / nloc;
        if (old + 1u == (gen + 1u) * nloc) {
            if (glob) {
            __builtin_amdgcn_fence(__ATOMIC_RELEASE, "agent");
            asm volatile("s_waitcnt vmcnt(0)" ::: "memory");
            const unsigned og = xb_add(&bar[XB_TOP], 1u);
            const unsigned tg = og / nx;
            if (og + 1u == (tg + 1u) * nx) xb_add(&bar[XB_TOPGEN], 1u);
            else XB_SPIN(xb_ld(&bar[XB_TOPGEN]) == tg, bar);
            }
            __builtin_amdgcn_fence(__ATOMIC_ACQUIRE, "agent");
            xb_add(&bar[XB_XGEN(b.x)], 1u);
            asm volatile("s_waitcnt vmcnt(0)" ::: "memory");
        } else {
            XB_SPIN(xb_ld(&bar[XB_XGEN(b.x)]) == gen, bar);
            __builtin_amdgcn_fence(__ATOMIC_ACQUIRE, "agent");
            asm volatile("s_waitcnt vmcnt(0)" ::: "memory");
        }
    }
    __syncthreads();
}

#ifndef DIS_PRO
#define DIS_PRO 0
#endif
#ifndef DIS_G0
#define DIS_G0 0
#endif
#ifndef DIS_PRE
#define DIS_PRE 0
#endif
#ifndef DIS_SCAN
#define DIS_SCAN 0
#endif
#ifndef DIS_SGU
#define DIS_SGU 0
#endif
#ifndef DIS_G3
#define DIS_G3 0
#endif
#ifndef DIS_G5
#define DIS_G5 0
#endif
#ifndef DIS_G6
#define DIS_G6 0
#endif
#ifndef GRID_SYNC
#define GRID_SYNC() cg::this_grid().sync()
#endif
#ifndef DIS_NORM
#define DIS_NORM 0
#endif
#ifndef REP_SCAN
#define REP_SCAN 1
#endif
#ifndef REP_PRE
#define REP_PRE 1
#endif
#ifndef REP_PRO
#define REP_PRO 1
#endif
#ifndef REP_G0
#define REP_G0 1
#endif
#ifndef REP_G5
#define REP_G5 1
#endif
#ifndef REP_NORM
#define REP_NORM 1
#endif
#ifndef REP_SGU
#define REP_SGU 1
#endif
#ifndef REP_G3
#define REP_G3 1
#endif
struct Args { const float* in[19]; float* out; unsigned char* ws; int ph_lo, ph_hi; };
constexpr int N_PHASES = 2 + 6 * NL;
__global__ void __launch_bounds__(NT, 2) hymba_fwd(Args args) {
    extern __shared__ __attribute__((aligned(16))) unsigned char lds_raw[];
    LAS unsigned char* lds = (LAS unsigned char*)lds_raw;
    Ctx X;
    X.x = args.in[0]; X.norm_mix = args.in[1]; X.w_in = args.in[2]; X.gla_a2 = args.in[3]; X.gla_ab = args.in[4]; X.gla_norm = args.in[5]; X.ml_conv = args.in[6]; X.ml_ib = args.in[7];
    X.ml_fb = args.in[8]; X.ml_norm = args.in[9]; X.sgu_ln_g = args.in[10]; X.sgu_ln_b = args.in[11]; X.sgu_w = args.in[12]; X.sgu_b = args.in[13]; X.w_out = args.in[14]; X.norm_ffn = args.in[15];
    X.w_gu = args.in[16]; X.w_down = args.in[17]; X.norm_final = args.in[18]; X.out = args.out; X.ws = args.ws;
    X.xn = (bf16*)(args.ws + WS_XN); X.proj = (bf16*)(args.ws + WS_PROJ); X.act = (bf16*)(args.ws + WS_PROJ); X.mix = (bf16*)(args.ws + WS_MIX);
    X.qg = (bf16*)(args.ws + WS_QG); X.kg = (bf16*)(args.ws + WS_KG); X.qm = (bf16*)(args.ws + WS_QM); X.km = (bf16*)(args.ws + WS_KM);
    X.elast = (float*)(args.ws + WS_ELAST); X.cumf = (float*)(args.ws + WS_CUMF); X.pmx = (float*)(args.ws + WS_PMX);
    const int G = gridDim.x, bx = blockIdx.x, ngw = G * NWAVES;
    const int lo = args.ph_lo, hi = args.ph_hi;
#define IN(k) (lo <= (k) && (k) < hi)
    if (threadIdx.x < 16) ((LAS unsigned*)(lds + LDS_CTL_OFF))[threadIdx.x] = 0u;
    __syncthreads();
    const XcdBarrier xbar = xcd_barrier_post((unsigned*)(args.ws + WS_CTL), (volatile LAS unsigned*)(lds + LDS_CTL_OFF));
    if (threadIdx.x == 0) { unsigned* ctl_ = (unsigned*)(args.ws + WS_CTL); const unsigned x_ = xb_xcc_id();
        const unsigned rk_ = __hip_atomic_fetch_add(ctl_ + 3584 + x_, 1u, __ATOMIC_RELAXED, __HIP_MEMORY_SCOPE_AGENT);
        if (rk_ >= 32u || x_ >= 8u || G != 256) __hip_atomic_store(ctl_ + 3616, 1u, __ATOMIC_RELAXED, __HIP_MEMORY_SCOPE_AGENT);
        ((volatile LAS unsigned*)(lds + LDS_CTL_OFF))[4] = rk_ * 8u + x_; }
#define SEAM(k) do { if (IN(k) && IN((k) + 1)) { if (lo < 0) GRID_SYNC(); else xcd_barrier(xbar); } } while (0)
#define SEAML(k) do { if (IN(k) && IN((k) + 1)) xcd_barrier(xbar, !xloc); } while (0)
    unsigned long long* ssq = (unsigned long long*)(args.ws + WS_SSQ);
    if (IN(0) && !DIS_PRO) for (int rep_ = 0; rep_ < REP_PRO; ++rep_) {
        for (int i = bx * NT + (int)threadIdx.x; i < 4 * M; i += G * NT) ssq[M + i] = 0ull;
        convert_weights(X, lds, bx * NWAVES, ngw, 0, I_IN + I_OUT + I_GU); rows_bf16_ssq(X.x, X.xn, ssq, bx * NWAVES, ngw); }
    SEAM(0);
    int cx = bx;
    { const unsigned bad_ = __hip_atomic_load((unsigned*)(args.ws + WS_CTL) + 3616, __ATOMIC_RELAXED, __HIP_MEMORY_SCOPE_AGENT);
      const int c_ = (int)((volatile LAS unsigned*)(lds + LDS_CTL_OFF))[4]; if (!bad_) cx = __builtin_amdgcn_readfirstlane(c_); }
    const bool xloc = (cx != bx) || (G == 256 && __hip_atomic_load((unsigned*)(args.ws + WS_CTL) + 3616, __ATOMIC_RELAXED, __HIP_MEMORY_SCOPE_AGENT) == 0u);
    const int xb_ = cx & 7, xj_ = cx >> 3;
    for (int l = 0; l < NL; ++l) {
        const int pb = 1 + 6 * l; unsigned char* wl = args.ws + (size_t)l * WS_LAYER;
        const float* xin = (l == 0) ? X.x : X.out;
        if (IN(pb + 0) && !DIS_G0) for (int rep_ = 0; rep_ < REP_G0; ++rep_) { pg8::Gemm gm{X.xn, (const bf16*)(wl + WS_WIN), M, PP, D}; pg8::StaticOrder S; S.init(M, PP, G, cx);
            pg8::EpiProj E{X.proj, PP, X.gla_norm + l * 768, X.ml_norm + l * 768, ssq + (size_t)(2 * l) * M, 1.0f / D, EPS};
            pg8::gemm_phase<pg8::EpiProj, pg8::StaticOrder, true, true>(lds, gm, S, E); }
        SEAML(pb + 0);
        if (IN(pb + 1) && !DIS_PRE) for (int rep_ = 0; rep_ < REP_PRE; ++rep_) { if (xloc) prepass_item(X, l, xb_ * 32 + xj_, lds); else for (int it = bx; it < 256; it += G) prepass_item(X, l, it, lds); }
        SEAML(pb + 1);
        if (IN(pb + 2)) for (int rep_ = 0; rep_ < REP_SCAN; ++rep_) {
            if (xloc) {
                if (xj_ < 8) { if (xj_ & 1) scan_item<true>(X, l, xb_, xj_ >> 1, lds); else scan_item<false>(X, l, xb_, xj_ >> 1, lds); }
                else { for (int it = xj_ - 8; it < 64; it += 24) sgu_item(X, l, xb_ * 64 + it, lds);
                    if (rep_ == 0) convert_weights(X, lds, (xb_ * 24 + xj_ - 8) * NWAVES, 192 * NWAVES, l == 0 ? I_IN + I_OUT + I_GU : I_L + I_IN + I_OUT, l == 0 ? I_L + I_IN + I_OUT : 2 * I_L); }
            } else {
            if (DIS_SCAN) {} else if (bx < 64) { if (bx & 1) scan_item<true>(X, l, bx >> 3, (bx >> 1) & 3, lds); else scan_item<false>(X, l, bx >> 3, (bx >> 1) & 3, lds); }
            else if (!DIS_SGU) for (int rs_ = 0; rs_ < REP_SGU; ++rs_) { for (int it = bx - 64; it < 512; it += G - 64) sgu_item(X, l, it, lds); }
            if (bx >= 64 && rep_ == 0) convert_weights(X, lds, (bx - 64) * NWAVES, (G - 64) * NWAVES, l == 0 ? I_IN + I_OUT + I_GU : I_L + I_IN + I_OUT, l == 0 ? I_L + I_IN + I_OUT : 2 * I_L);
            }
        }
        SEAM(pb + 2);
        if (IN(pb + 3) && !DIS_G3) { pg8::Gemm gm{X.mix, (const bf16*)(wl + WS_WOUT), M, D, D}; pg8::StaticOrder S; S.init(M, D, G, cx); pg8::EpiResid E{nullptr, nullptr, D, X.xn, ssq + (size_t)(2 * l + 1) * M};
            pg8::gemm_phase<pg8::EpiResid, pg8::StaticOrder, true, true>(lds, gm, S, E); }
        SEAML(pb + 3);
        if (IN(pb + 4) && !DIS_G5) for (int rep_ = 0; rep_ < REP_G5; ++rep_) { pg8::Gemm gm{X.xn, (const bf16*)(wl + WS_WGU), M, NGU, D}; pg8::StaticOrder S; S.init(M, NGU, G, cx);
            pg8::EpiSwiGLU E{X.act, FF, ssq + (size_t)(2 * l + 1) * M, 1.0f / D, EPS};
            pg8::gemm_phase<pg8::EpiSwiGLU, pg8::StaticOrder, true, true>(lds, gm, S, E); }
        SEAML(pb + 4);
        if (IN(pb + 5) && !DIS_G6) { pg8::Gemm gm{X.act, (const bf16*)(wl + WS_WDN), M, D, FF}; pg8::StaticOrder S; S.init(M, D, G, cx); pg8::EpiResid E{nullptr, nullptr, D, X.xn, ssq + (size_t)(2 * l + 2) * M};
            pg8::gemm_phase<pg8::EpiResid, pg8::StaticOrder, true, true>(lds, gm, S, E); }
        if (l + 1 < NL) SEAM(pb + 5); else SEAML(pb + 5);
    }
    if (IN(1 + 6 * NL) && !DIS_NORM) {
        if (xloc) { const size_t r0 = (size_t)xb_ * SEQ;
            rows_final_norm(X.xn + r0 * D, X.out + r0 * D, X.norm_final, ssq + (size_t)4 * M + r0, xj_ * NWAVES, 32 * NWAVES, SEQ); }
        else rows_final_norm(X.xn, X.out, X.norm_final, ssq + (size_t)4 * M, bx * NWAVES, ngw, M);
    }
#undef IN
#undef SEAM
}

#ifndef MK_ONE_LAUNCH
#define MK_ONE_LAUNCH 1
#endif
extern "C" void kernel_launch(void* const* d_in, const int* in_sizes, int n_in, void* d_out, int out_size, void* d_ws, size_t ws_size, hipStream_t stream) {
    static int grid = 0;
    if (grid == 0) {
        if (n_in != 19 || out_size != M * D || ws_size < WS_END) { fprintf(stderr, "kernel_launch: unexpected shapes (n_in %d out %d ws %zu)\n", n_in, out_size, ws_size); grid = -1; return; }
        int dev = 0, cus = 0, per_cu = 0;
        hipGetDevice(&dev); hipDeviceGetAttribute(&cus, hipDeviceAttributeMultiprocessorCount, dev);
        if (hipFuncSetAttribute((const void*)hymba_fwd, hipFuncAttributeMaxDynamicSharedMemorySize, LDS_BYTES) != hipSuccess) { fprintf(stderr, "kernel_launch: hipFuncSetAttribute failed\n"); grid = -1; return; }
        if (hipOccupancyMaxActiveBlocksPerMultiprocessor(&per_cu, (const void*)hymba_fwd, NT, LDS_BYTES) != hipSuccess || per_cu < 1) { fprintf(stderr, "kernel_launch: occupancy query gave %d\n", per_cu); per_cu = 1; }
        (void)hipGetLastError();
        grid = cus * 1;
        if (grid > cus * per_cu) grid = cus * per_cu;
    }
    if (grid < 0) return;
    if (hipMemsetAsync((char*)d_ws + WS_CTL, 0, CTL_BYTES, stream) != hipSuccess) { fprintf(stderr, "kernel_launch: memset failed\n"); return; }
    Args a{};
    for (int i = 0; i < 19; ++i) a.in[i] = (const float*)d_in[i];
    a.out = (float*)d_out; a.ws = (unsigned char*)d_ws;
#if MK_ONE_LAUNCH
    a.ph_lo = 0; a.ph_hi = N_PHASES;
    void* kargs[] = {&a};
    hipError_t e = hipLaunchCooperativeKernel((const void*)hymba_fwd, dim3(grid), dim3(NT), kargs, LDS_BYTES, stream);
    if (e != hipSuccess) fprintf(stderr, "kernel_launch: cooperative launch failed: %s (grid %d)\n", hipGetErrorString(e), grid);
#else
    for (int p = 0; p < N_PHASES; ++p) { a.ph_lo = p; a.ph_hi = p + 1; hipLaunchKernelGGL(hymba_fwd, dim3(grid), dim3(NT), LDS_BYTES, stream, a); }
#endif
}
```

```cpp
#include <hip/hip_runtime.h>
#include <hip/hip_cooperative_groups.h>
#include <cstdio>
#include <cstdint>
namespace cg = cooperative_groups;
namespace pg8 {
#define PG8_LAS __attribute__((address_space(3)))
typedef unsigned short bf16_t;
typedef short bf16x8 __attribute__((ext_vector_type(8)));
typedef float f32x4 __attribute__((ext_vector_type(4)));
typedef unsigned u32x4 __attribute__((ext_vector_type(4)));
constexpr int BM = 256, BK = 64, HALF = 128, HTB = HALF * BK * 2  , STAGE_BYTES = 8 * HTB, NXCD = 8, WGM = 8;

__host__ __device__ __forceinline__ int lds_byte(int r, int c) { const int st = (r >> 4) * 2 + (c >> 5), rr = r & 15, cc = c & 31, ob = rr * 64 + cc * 2; return st * 1024 + (ob ^ (((ob >> 9) & 1) << 5)); }
__host__ __device__ __forceinline__ void stage_rc(int b, int& R, int& C) { const int st = b / 1024, sb = b % 1024, swz = sb ^ (((sb >> 9) & 1) << 5); R = (st >> 1) * 16 + swz / 64; C = (st & 1) * 32 + (swz % 64) / 2; }
__host__ __device__ __forceinline__ int perm32(int rho) { const int n = rho >> 4, i = rho & 15; return 8 * (i >> 2) + 4 * n + (i & 3); }

struct Unit { int pm, pn; };
struct Gemm { const bf16_t* A; const bf16_t* Bt; int M, N, K; };

struct StaticOrder {
    int nM, nN, nwg, G, c;
    __host__ __device__ void init(int M, int N, int G_, int c_) { nM = M / BM; nN = N / BM; nwg = nM * nN; G = G_; c = c_; }
    __host__ __device__ bool next(int i, Unit& u) const {
        const long L = (long)i * G + c; if (L >= nwg) return false;
        int wgid = (int)L; { const int q = nwg / NXCD, r = nwg % NXCD, xcd = wgid % NXCD, off = wgid / NXCD; wgid = (xcd < r ? xcd * (q + 1) : r * (q + 1) + (xcd - r) * q) + off; }
        const int nig = WGM * nN, gid = wgid / nig, fm = gid * WGM, gsz = (nM - fm) < WGM ? (nM - fm) : WGM;
        u.pm = fm + ((wgid % nig) % gsz); u.pn = (wgid % nig) / gsz; return true;
    }
    __device__ __forceinline__ void a_ready(const Unit&) const {}
    __device__ __forceinline__ void done(const Unit&) const {}
};
__device__ __forceinline__ unsigned cvt_pk_bf16(float lo, float hi) { unsigned r; asm volatile("v_cvt_pk_bf16_f32 %0, %1, %2" : "=v"(r) : "v"(lo), "v"(hi)); return r; }
typedef unsigned u32x2 __attribute__((ext_vector_type(2)));
struct EpiBf16 {
    static constexpr bool PERM = true, AFTER_DRAIN = false;
    bf16_t* O; int ldc;
    __device__ __forceinline__ void operator()(const f32x4 (&acc)[2][2][4][2], const Unit& u, int wr, int wc, int fr, int fq) const {
        const int row0 = u.pm * BM + wr * 64 + fr; const int col0 = u.pn * BM + wc * 32 + 8 * fq;
#pragma unroll
        for (int ai = 0; ai < 2; ++ai)
#pragma unroll
            for (int m = 0; m < 4; ++m) { bf16_t* rowp = O + (size_t)(row0 + ai * HALF + m * 16) * ldc + col0;
#pragma unroll
                for (int bj = 0; bj < 2; ++bj) { const f32x4 v0 = acc[ai][bj][m][0], v1 = acc[ai][bj][m][1];
                    u32x4 w; w.x = cvt_pk_bf16(v0[0], v0[1]); w.y = cvt_pk_bf16(v0[2], v0[3]); w.z = cvt_pk_bf16(v1[0], v1[1]); w.w = cvt_pk_bf16(v1[2], v1[3]);
                    *(u32x4*)(rowp + bj * HALF) = w; } }
    }
};
struct EpiResid {
    static constexpr bool PERM = false, AFTER_DRAIN = false;
    const float* basef; float* outf; int ldc; bf16_t* xb; unsigned long long* ssq;
    __device__ __forceinline__ void operator()(const f32x4 (&acc)[2][2][4][2], const Unit& u, int wr, int wc, int fr, int fq) const {
        const int row0 = u.pm * BM + wr * 64 + fr, col0 = u.pn * BM + wc * 32 + 4 * fq;
#pragma unroll
        for (int ai = 0; ai < 2; ++ai) {
            f32x4 bs[4][2][2];
            if (basef) {
#pragma unroll
                for (int m = 0; m < 4; ++m) { const size_t off = (size_t)(row0 + ai * HALF + m * 16) * ldc + col0;
#pragma unroll
                    for (int bj = 0; bj < 2; ++bj)
#pragma unroll
                        for (int n = 0; n < 2; ++n) bs[m][bj][n] = __builtin_nontemporal_load((const f32x4*)(basef + off + bj * HALF + n * 16)); }
            } else {
                u32x2 bw[4][2][2];
#pragma unroll
                for (int m = 0; m < 4; ++m) { const size_t off = (size_t)(row0 + ai * HALF + m * 16) * ldc + col0;
#pragma unroll
                    for (int bj = 0; bj < 2; ++bj)
#pragma unroll
                        for (int n = 0; n < 2; ++n) bw[m][bj][n] = *(const u32x2*)(xb + off + bj * HALF + n * 16); }
#pragma unroll
                for (int m = 0; m < 4; ++m)
#pragma unroll
                    for (int bj = 0; bj < 2; ++bj)
#pragma unroll
                        for (int n = 0; n < 2; ++n) { const u32x2 w = bw[m][bj][n];
                            bs[m][bj][n] = (f32x4){__uint_as_float(w.x << 16), __uint_as_float(w.x & 0xffff0000u), __uint_as_float(w.y << 16), __uint_as_float(w.y & 0xffff0000u)}; }
            }
#pragma unroll
            for (int m = 0; m < 4; ++m) { const int row = row0 + ai * HALF + m * 16; const size_t off = (size_t)row * ldc + col0;
                float s = 0.f;
#pragma unroll
                for (int bj = 0; bj < 2; ++bj)
#pragma unroll
                    for (int n = 0; n < 2; ++n) { const f32x4 y = bs[m][bj][n] + acc[ai][bj][m][n];
                        if (outf) __builtin_nontemporal_store(y, (f32x4*)(outf + off + bj * HALF + n * 16));
                        else { u32x2 w; w.x = cvt_pk_bf16(y[0], y[1]); w.y = cvt_pk_bf16(y[2], y[3]); *(u32x2*)(xb + off + bj * HALF + n * 16) = w; }
                        s += (y[0] * y[0] + y[1] * y[1]) + (y[2] * y[2] + y[3] * y[3]); }
                s += __shfl_xor(s, 16); s += __shfl_xor(s, 32);
                if (fq == 0) atomicAdd(ssq + row, (unsigned long long)(s * 1048576.0f + 0.5f)); }
            asm volatile("" ::: "memory");
        }
    }
};
struct EpiSwiGLU {
    static constexpr bool PERM = true, AFTER_DRAIN = false;
    bf16_t* O; int ldc; const unsigned long long* ssq; float invd, eps;
    __device__ __forceinline__ void operator()(const f32x4 (&acc)[2][2][4][2], const Unit& u, int wr, int wc, int fr, int fq) const {
        const int row0 = u.pm * BM + wr * 64 + fr; const int col0 = u.pn * HALF + wc * 32 + 8 * fq;
        float rsv[2][4];
#pragma unroll
        for (int ai = 0; ai < 2; ++ai)
#pragma unroll
            for (int m = 0; m < 4; ++m) rsv[ai][m] = (float)ssq[row0 + ai * HALF + m * 16] * (1.0f / 1048576.0f);
#pragma unroll
        for (int ai = 0; ai < 2; ++ai)
#pragma unroll
            for (int m = 0; m < 4; ++m) rsv[ai][m] = 1.0f / sqrtf(rsv[ai][m] * invd + eps);
#pragma unroll
        for (int ai = 0; ai < 2; ++ai)
#pragma unroll
            for (int m = 0; m < 4; ++m) { bf16_t* rowp = O + (size_t)(row0 + ai * HALF + m * 16) * ldc + col0;
                const float rs = rsv[ai][m];
                float r[8];
#pragma unroll
                for (int n = 0; n < 2; ++n)
#pragma unroll
                    for (int j = 0; j < 4; ++j) { const float gt = acc[ai][0][m][n][j] * rs, up = acc[ai][1][m][n][j] * rs;
                        r[n * 4 + j] = gt * __builtin_amdgcn_rcpf(1.0f + __expf(-gt)) * up; }
                u32x4 w; w.x = cvt_pk_bf16(r[0], r[1]); w.y = cvt_pk_bf16(r[2], r[3]); w.z = cvt_pk_bf16(r[4], r[5]); w.w = cvt_pk_bf16(r[6], r[7]);
                *(u32x4*)rowp = w; }
    }
};

struct EpiProj {
    static constexpr bool PERM = true, AFTER_DRAIN = false;
    bf16_t* O; int ldc; const float* cs1; const float* cs2;
    const unsigned long long* ssq; float invd, eps;
    __device__ __forceinline__ void operator()(const f32x4 (&acc)[2][2][4][2], const Unit& u, int wr, int wc, int fr, int fq) const {
        const int row0 = u.pm * BM + wr * 64 + fr; const int col0 = u.pn * BM + wc * 32 + 8 * fq;
        const int kind = (u.pn >= 6 && u.pn < 9) ? 1 : (u.pn >= 15 && u.pn < 18) ? 2 : (u.pn >= 18 && u.pn < 22) ? 3 : 0;
        float rsv[2][4];
#pragma unroll
        for (int ai = 0; ai < 2; ++ai)
#pragma unroll
            for (int m = 0; m < 4; ++m) rsv[ai][m] = (float)ssq[row0 + ai * HALF + m * 16] * (1.0f / 1048576.0f);
#pragma unroll
        for (int ai = 0; ai < 2; ++ai)
#pragma unroll
            for (int m = 0; m < 4; ++m) rsv[ai][m] = 1.0f / sqrtf(rsv[ai][m] * invd + eps);
        f32x4 sc[2][2];
#pragma unroll
        for (int bj = 0; bj < 2; ++bj)
#pragma unroll
            for (int n = 0; n < 2; ++n) sc[bj][n] = (f32x4){1.f, 1.f, 1.f, 1.f};
        if (kind == 1 || kind == 2) { const float* cs = (kind == 1) ? cs1 + (col0 - 6 * BM) : cs2 + (col0 - 15 * BM);
#pragma unroll
            for (int bj = 0; bj < 2; ++bj)
#pragma unroll
                for (int n = 0; n < 2; ++n) sc[bj][n] = *(const f32x4*)(cs + bj * HALF + 4 * n); }
#pragma unroll
        for (int ai = 0; ai < 2; ++ai)
#pragma unroll
            for (int m = 0; m < 4; ++m) { bf16_t* rowp = O + (size_t)(row0 + ai * HALF + m * 16) * ldc + col0;
                const float rs = rsv[ai][m];
#pragma unroll
                for (int bj = 0; bj < 2; ++bj) { if (u.pn == 22 && (bj != 0 || wc != 0)) continue;
                    f32x4 v[2] = {acc[ai][bj][m][0] * rs, acc[ai][bj][m][1] * rs};
                    if (kind != 0) {
#pragma unroll
                        for (int n = 0; n < 2; ++n)
#pragma unroll
                            for (int j = 0; j < 4; ++j) { const float x = v[n][j];
                                const float z = (kind == 3) ? 1.5957691216057308f * (x + 0.044715f * x * x * x) : x;
                                const float sg = __builtin_amdgcn_rcpf(1.0f + __expf(-z));
                                v[n][j] = ((kind == 2) ? sg : x * sg) * sc[bj][n][j]; }
                    }
                    u32x4 w; w.x = cvt_pk_bf16(v[0][0], v[0][1]); w.y = cvt_pk_bf16(v[0][2], v[0][3]); w.z = cvt_pk_bf16(v[1][0], v[1][1]); w.w = cvt_pk_bf16(v[1][2], v[1][3]);
                    *(u32x4*)(rowp + bj * HALF) = w; } }
    }
};
template <class Epi, class Sched, bool ALIGN_EPI = false, bool SP2 = false>
__device__ __forceinline__ void gemm_phase(PG8_LAS unsigned char* lds, const Gemm g, const Sched& S, const Epi& E) {
    int tid_ = threadIdx.x; asm volatile("" : "+v"(tid_)); const int tid = tid_, wid = __builtin_amdgcn_readfirstlane(tid >> 6), lane = tid & 63, wr = wid >> 2, wc = wid & 3, fr = lane & 15, fq = lane >> 4;
    const int K = g.K, nt = K / BK;
    unsigned voffA[2], voffB[2];
#pragma unroll
    for (int i = 0; i < 2; ++i) { int R, C; stage_rc(tid * 16 + i * 8192, R, C); const int Rb = Epi::PERM ? ((R & ~31) + perm32(R & 31)) : R;
        voffA[i] = (unsigned)(R * K + C) * 2u; voffB[i] = (unsigned)(Rb * K + C) * 2u; }
    const size_t kstep = (size_t)(BK * 2);
    const size_t hstep = (size_t)HALF * K * 2;
    const size_t tstep = 2 * hstep;
    const unsigned ldsw = (unsigned)wid * 1024u;
    const int aoff = lds_byte(wr * 64 + fr, fq * 8), boff = lds_byte(wc * 32 + fr, fq * 8);
#define PG8_SA(b, h) (((b) * 2 + (h)) * HTB)
#define PG8_SB(b, h) ((4 + (b) * 2 + (h)) * HTB)
#define PG8_STAGE(bufoff, gbase, voff) do { _Pragma("unroll") for (int _i = 0; _i < 2; ++_i) \
        __builtin_amdgcn_global_load_lds((const unsigned*)((const char*)(gbase) + (voff)[_i]), (PG8_LAS unsigned*)(lds + (bufoff) + ldsw + _i * 8192), 16, 0, 0); } while (0)
#define PG8_LDA(dst, b, h) do { _Pragma("unroll") for (int m = 0; m < 4; ++m) _Pragma("unroll") for (int k = 0; k < 2; ++k) dst[m][k] = *(const PG8_LAS bf16x8*)(lds + PG8_SA(b, h) + aoff + m * 2048 + k * 1024); } while (0)
#define PG8_LDB(dst, b, h) do { _Pragma("unroll") for (int n = 0; n < 2; ++n) _Pragma("unroll") for (int k = 0; k < 2; ++k) dst[n][k] = *(const PG8_LAS bf16x8*)(lds + PG8_SB(b, h) + boff + n * 2048 + k * 1024); } while (0)
#define PG8_MMA(ai, bj, At, Bt) do { __builtin_amdgcn_s_setprio(1); _Pragma("unroll") for (int m = 0; m < 4; ++m) _Pragma("unroll") for (int n = 0; n < 2; ++n) _Pragma("unroll") for (int k = 0; k < 2; ++k) \
        acc[ai][bj][m][n] = __builtin_amdgcn_mfma_f32_16x16x32_bf16(Bt[n][k], At[m][k], acc[ai][bj][m][n], 0, 0, 0); __builtin_amdgcn_s_setprio(0); } while (0)
#define PG8_WAIT_V(n) asm volatile("s_waitcnt vmcnt(" #n ")" ::: "memory")
#define PG8_WAIT_L(n) asm volatile("s_waitcnt lgkmcnt(" #n ")" ::: "memory")
#define PG8_BAR __builtin_amdgcn_s_barrier()
#define PG8_SCHED __builtin_amdgcn_sched_barrier(0)
    Unit cur, nxt; int ui = 0;
    if (!S.next(0, cur)) return;
    f32x4 acc[2][2][4][2];
#pragma unroll
    for (int a = 0; a < 2; ++a)
#pragma unroll
        for (int b = 0; b < 2; ++b)
#pragma unroll
            for (int m = 0; m < 4; ++m)
#pragma unroll
                for (int n = 0; n < 2; ++n) acc[a][b][m][n] = (f32x4){0.f, 0.f, 0.f, 0.f};
    bf16x8 At[4][2], B0[2][2], B1[2][2];
    const char* cA = (const char*)g.A + (size_t)cur.pm * tstep; const char* cB = (const char*)g.Bt + (size_t)cur.pn * tstep;
    S.a_ready(cur);
    if constexpr (SP2) {
        PG8_STAGE(PG8_SB(0, 0), cB, voffB); PG8_STAGE(PG8_SB(0, 1), cB + hstep, voffB); PG8_STAGE(PG8_SA(0, 0), cA, voffA); PG8_STAGE(PG8_SA(0, 1), cA + hstep, voffA);
        if (wr == 1) PG8_BAR;
        PG8_WAIT_V(2); PG8_BAR;
        PG8_STAGE(PG8_SB(1, 0), cB + kstep, voffB); PG8_STAGE(PG8_SA(1, 0), cA + kstep, voffA); PG8_STAGE(PG8_SB(1, 1), cB + hstep + kstep, voffB);
        PG8_WAIT_V(6); PG8_BAR;
    } else {
        PG8_STAGE(PG8_SB(0, 0), cB, voffB); PG8_STAGE(PG8_SA(0, 0), cA, voffA); PG8_STAGE(PG8_SB(0, 1), cB + hstep, voffB); PG8_STAGE(PG8_SA(0, 1), cA + hstep, voffA);
        if (wr == 1) PG8_BAR;
        PG8_WAIT_V(4); PG8_BAR;
        PG8_STAGE(PG8_SB(1, 0), cB + kstep, voffB); PG8_STAGE(PG8_SA(1, 0), cA + kstep, voffA); PG8_STAGE(PG8_SB(1, 1), cB + hstep + kstep, voffB);
        PG8_WAIT_V(6); PG8_BAR;
    }
    for (;;) {
        const bool has_next = S.next(ui + 1, nxt);
        const char* nA = has_next ? (const char*)g.A + (size_t)nxt.pm * tstep : cA; const char* nB = has_next ? (const char*)g.Bt + (size_t)nxt.pn * tstep : cB;
        for (int t = 0; t < nt; t += 2) {
            const bool last = (t == nt - 2);
            const char* a1 = cA + (size_t)(t + 1) * kstep;
            const char* a2 = last ? nA : cA + (size_t)(t + 2) * kstep; const char* b2 = last ? nB : cB + (size_t)(t + 2) * kstep;
            const char* a3 = a2 + kstep; const char* b3 = b2 + kstep;
            if (last && has_next) S.a_ready(nxt);
            if constexpr (SP2) {
            PG8_LDB(B0, 0, 0); PG8_LDB(B1, 0, 1); PG8_SCHED; PG8_LDA(At, 0, 0); PG8_STAGE(PG8_SA(1, 1), a1 + hstep, voffA);
            PG8_WAIT_V(8); PG8_WAIT_L(0); PG8_BAR; PG8_MMA(0, 0, At, B0); PG8_MMA(0, 1, At, B1); PG8_BAR; PG8_SCHED;
            PG8_LDA(At, 0, 1); PG8_STAGE(PG8_SB(0, 0), b2, voffB); PG8_STAGE(PG8_SB(0, 1), b2 + hstep, voffB); PG8_STAGE(PG8_SA(0, 0), a2, voffA);
            PG8_WAIT_V(8); PG8_WAIT_L(0); PG8_BAR; PG8_MMA(1, 0, At, B0); PG8_MMA(1, 1, At, B1); PG8_BAR; PG8_SCHED;
            PG8_LDB(B0, 1, 0); PG8_LDB(B1, 1, 1); PG8_SCHED; PG8_LDA(At, 1, 0); PG8_STAGE(PG8_SA(0, 1), a2 + hstep, voffA);
            PG8_WAIT_V(8); PG8_WAIT_L(0); PG8_BAR; PG8_MMA(0, 0, At, B0); PG8_MMA(0, 1, At, B1); PG8_BAR; PG8_SCHED;
            PG8_LDA(At, 1, 1); PG8_STAGE(PG8_SB(1, 0), b3, voffB); PG8_STAGE(PG8_SB(1, 1), b3 + hstep, voffB); PG8_STAGE(PG8_SA(1, 0), a3, voffA);
            PG8_WAIT_V(8); PG8_WAIT_L(0); PG8_BAR; PG8_MMA(1, 0, At, B0); PG8_MMA(1, 1, At, B1); PG8_BAR; PG8_SCHED;
            } else {
            PG8_LDB(B0, 0, 0); PG8_SCHED; PG8_LDA(At, 0, 0); PG8_STAGE(PG8_SA(1, 1), a1 + hstep, voffA);
            PG8_WAIT_L(8); PG8_BAR; PG8_WAIT_L(0); PG8_MMA(0, 0, At, B0); PG8_BAR; PG8_SCHED;
            PG8_LDB(B1, 0, 1); PG8_STAGE(PG8_SB(0, 0), b2, voffB);
            PG8_BAR; PG8_WAIT_L(0); PG8_MMA(0, 1, At, B1); PG8_BAR;
            PG8_LDA(At, 0, 1); PG8_STAGE(PG8_SA(0, 0), a2, voffA);
            PG8_BAR; PG8_WAIT_L(0); PG8_MMA(1, 0, At, B0); PG8_BAR; PG8_SCHED;
            PG8_STAGE(PG8_SB(0, 1), b2 + hstep, voffB);
            PG8_WAIT_V(6); PG8_BAR; PG8_MMA(1, 1, At, B1); PG8_BAR;
            PG8_LDB(B0, 1, 0); PG8_SCHED; PG8_LDA(At, 1, 0); PG8_STAGE(PG8_SA(0, 1), a2 + hstep, voffA);
            PG8_WAIT_L(8); PG8_BAR; PG8_WAIT_L(0); PG8_MMA(0, 0, At, B0); PG8_BAR; PG8_SCHED;
            PG8_LDB(B1, 1, 1); PG8_STAGE(PG8_SB(1, 0), b3, voffB);
            PG8_BAR; PG8_WAIT_L(0); PG8_MMA(0, 1, At, B1); PG8_BAR;
            PG8_LDA(At, 1, 1); PG8_STAGE(PG8_SA(1, 0), a3, voffA);
            PG8_BAR; PG8_WAIT_L(0); PG8_MMA(1, 0, At, B0); PG8_BAR; PG8_SCHED;
            PG8_STAGE(PG8_SB(1, 1), b3 + hstep, voffB);
            PG8_WAIT_V(6); PG8_BAR; PG8_MMA(1, 1, At, B1); PG8_BAR;
            }
        }
        if constexpr (ALIGN_EPI) { if (wr == 0) PG8_BAR; }
        if constexpr (!Epi::AFTER_DRAIN) { E(acc, cur, wr, wc, fr, fq); S.done(cur); }
        if (!has_next) break;
#pragma unroll
        for (int a = 0; a < 2; ++a)
#pragma unroll
            for (int b = 0; b < 2; ++b)
#pragma unroll
                for (int m = 0; m < 4; ++m)
#pragma unroll
                    for (int n = 0; n < 2; ++n) acc[a][b][m][n] = (f32x4){0.f, 0.f, 0.f, 0.f};
        cur = nxt; cA = nA; cB = nB; ++ui;
        if constexpr (ALIGN_EPI) { if (wr == 1) PG8_BAR; }
    }
    PG8_WAIT_V(0);
    if constexpr (!ALIGN_EPI) { if (wr == 0) PG8_BAR; }
    PG8_BAR;
    if constexpr (Epi::AFTER_DRAIN) { E.fused(acc, cur, wr, wc, fr, fq, lds, wid, lane); S.done(cur); }
#undef PG8_SA
#undef PG8_SB
#undef PG8_STAGE
#undef PG8_LDA
#undef PG8_LDB
#undef PG8_MMA
#undef PG8_WAIT_V
#undef PG8_WAIT_L
#undef PG8_BAR
#undef PG8_SCHED
}
}

#define LAS __attribute__((address_space(3)))
typedef unsigned short bf16;
typedef float f32x4 __attribute__((ext_vector_type(4)));
typedef short bf16x8 __attribute__((ext_vector_type(8)));
typedef short s16x4 __attribute__((ext_vector_type(4)));
typedef unsigned u32x4 __attribute__((ext_vector_type(4)));
typedef unsigned u32x2 __attribute__((ext_vector_type(2)));

constexpr int NWAVES = 8, NT = 512;
constexpr int SEQ = 2048, M = 16384, D = 2048, NL = 2;
constexpr int P = 5656, PP = 5888, FF = 5632, NGU = 11264;
constexpr int GQ = 0, GK = 384, GV = 768, GG = 1536, MQ = 2304, MK = 2688, MV = 3072, MO = 3840, SU = 4608, SV = 5120, GA1 = 5632, MI = 5648, MF = 5652;
constexpr float EPS = 1e-6f;
constexpr float QK_SCALE = 0.10206207261596577f;
constexpr size_t MiB = 1u << 20;
constexpr size_t WS_LAYER = 97 * MiB, WS_WIN = 0, WS_WOUT = 23 * MiB, WS_WGU = 31 * MiB, WS_WDN = 75 * MiB;
constexpr size_t WS_XN = 194 * MiB, WS_PROJ = 258 * MiB, WS_MIX = 442 * MiB, WS_QG = 506 * MiB, WS_KG = 518 * MiB, WS_QM = 530 * MiB, WS_KM = 542 * MiB;
constexpr size_t WS_ELAST = 554 * MiB, WS_CUMF = 555 * MiB, WS_PMX = 556 * MiB, WS_CTL = 557 * MiB, WS_SSQ = 558 * MiB, WS_END = 559 * MiB;
constexpr size_t CTL_BYTES = 16384;

constexpr int LDS_BYTES = 147456;
constexpr int LDS_CTL_OFF = LDS_BYTES - 64;

struct Ctx {
    const float *x, *norm_mix, *w_in, *gla_a2, *gla_ab, *gla_norm, *ml_conv, *ml_ib, *ml_fb, *ml_norm, *sgu_ln_g, *sgu_ln_b, *sgu_w, *sgu_b, *w_out, *norm_ffn, *w_gu, *w_down, *norm_final;
    float* out; unsigned char* ws;
    bf16 *xn, *proj, *act, *mix, *qg, *kg, *qm, *km; float *elast, *cumf, *pmx;
};

__device__ __forceinline__ float bf2f(unsigned v) { return __uint_as_float(v << 16); }
__device__ __forceinline__ unsigned f2bf(float f) { unsigned u = __float_as_uint(f); return (u + 0x7fffu + ((u >> 16) & 1u)) >> 16; }
__device__ __forceinline__ unsigned pk2(float lo, float hi) { return pg8::cvt_pk_bf16(lo, hi); }
__device__ __forceinline__ float lo16(unsigned w) { return __uint_as_float(w << 16); }
__device__ __forceinline__ float hi16(unsigned w) { return __uint_as_float(w & 0xffff0000u); }
__device__ __forceinline__ float wave_sum(float v) {
#pragma unroll
    for (int o = 1; o < 64; o <<= 1) v += __shfl_xor(v, o);
    return v;
}
__device__ __forceinline__ float logsig(float z) { return fminf(z, 0.f) - log1pf(__expf(-fabsf(z))); }
__device__ __forceinline__ float logsig_fast(float z) { return fminf(z, 0.f) - __logf(1.0f + __expf(-fabsf(z))); }
__device__ __forceinline__ float sigmoidf_(float z) { return __builtin_amdgcn_rcpf(1.0f + __expf(-z)); }
__device__ __forceinline__ float gelu_tanh(float x) { const float u = 0.7978845608028654f * (x + 0.044715f * x * x * x); return x * sigmoidf_(2.0f * u); }
__device__ __forceinline__ s16x4 vtr(const LAS unsigned char* p) { typedef short v4i16_t __attribute__((ext_vector_type(4))); return __builtin_bit_cast(s16x4, __builtin_amdgcn_ds_read_tr16_b64_v4i16((LAS v4i16_t*)p)); }
__device__ __forceinline__ bf16x8 vtr2(const LAS unsigned char* p, int step) { const s16x4 lo = vtr(p), hi = vtr(p + step); return __builtin_shufflevector(lo, hi, 0, 1, 2, 3, 4, 5, 6, 7); }
__device__ __forceinline__ bf16x8 ld128(const LAS unsigned char* p) { return *(const LAS bf16x8*)p; }
#define WG_BAR() do { asm volatile("s_waitcnt lgkmcnt(0)" ::: "memory"); __builtin_amdgcn_s_barrier(); asm volatile("" ::: "memory"); } while (0)
#define MFMA16(a, b, c) __builtin_amdgcn_mfma_f32_16x16x32_bf16((a), (b), (c), 0, 0, 0)

constexpr int I_IN = 32 * (PP / 32), I_OUT = 32 * (D / 32), I_GU = 32 * (NGU / 32), I_DN = (FF / 64) * (D / 32), I_L = I_IN + I_OUT + I_GU + I_DN;
template <bool REMAP> __device__ __forceinline__ void transpose_item(const float* W, int K, int N, bf16* WT, int dst_row0, int k0, int n0, LAS float* scr, int lane, const float* gk) {
    int n = n0 + (lane & 31); bool ok = n < N;
    if (REMAP) { const int d = n;
        n = d < 2304 ? d : d < 4608 ? d + 16 : d < 5632 ? d + 24 : d < 5648 ? d - 5632 + 2304 : d < 5656 ? d - 5648 + 4624 : 0; ok = d < 5656; }
    float wv_[32];
#pragma unroll
    for (int i = 0; i < 32; ++i) { const int kk = 2 * i + (lane >> 5); wv_[i] = ok ? W[(size_t)(k0 + kk) * N + n] : 0.f; }
#pragma unroll
    for (int i = 0; i < 32; ++i) { const int kk = 2 * i + (lane >> 5); scr[kk * 33 + (lane & 31)] = wv_[i]; }
    asm volatile("s_waitcnt lgkmcnt(0)" ::: "memory");
    const int c = lane & 7;
    f32x4 g0 = (f32x4){1.f, 1.f, 1.f, 1.f}, g1 = g0;
    if (gk) { g0 = *(const f32x4*)(gk + k0 + 8 * c); g1 = *(const f32x4*)(gk + k0 + 8 * c + 4); }
#pragma unroll
    for (int j = 0; j < 4; ++j) { const int nn = (lane >> 3) + 8 * j; const LAS float* s = scr + (8 * c) * 33 + nn;
        u32x4 o; o.x = pk2(s[0 * 33] * g0.x, s[1 * 33] * g0.y); o.y = pk2(s[2 * 33] * g0.z, s[3 * 33] * g0.w); o.z = pk2(s[4 * 33] * g1.x, s[5 * 33] * g1.y); o.w = pk2(s[6 * 33] * g1.z, s[7 * 33] * g1.w);
        *(u32x4*)(WT + (size_t)(dst_row0 + nn) * K + k0 + 8 * c) = o; }
    asm volatile("s_waitcnt lgkmcnt(0)" ::: "memory");
}
__device__ __forceinline__ void convert_weights(const Ctx& X, LAS unsigned char* lds, int gwb, int ngw, int it_lo, int it_hi) {
    int tid_ = threadIdx.x; asm volatile("" : "+v"(tid_)); const int lane = tid_ & 63, wave = __builtin_amdgcn_readfirstlane(tid_ >> 6), gw = gwb + wave;
    LAS float* scr = (LAS float*)(lds + wave * 16384);
    for (int it = it_lo + gw; it < it_hi; it += ngw) {
        const int l = it / I_L; int r = it - l * I_L; unsigned char* wl = X.ws + (size_t)l * WS_LAYER;
        if (r < I_IN) { const int nb = PP / 32, kb = r / nb, n0 = 32 * (r % nb); transpose_item<true>(X.w_in + (size_t)l * D * P, D, P, (bf16*)(wl + WS_WIN), n0, 64 * kb, n0, scr, lane, X.norm_mix + l * D); continue; } r -= I_IN;
        if (r < I_OUT) { const int nb = D / 32, kb = r / nb, n0 = 32 * (r % nb); transpose_item<false>(X.w_out + (size_t)l * D * D, D, D, (bf16*)(wl + WS_WOUT), n0, 64 * kb, n0, scr, lane, nullptr); continue; } r -= I_OUT;
        if (r < I_GU) { const int nb = NGU / 32, kb = r / nb, n0 = 32 * (r % nb); const int up = n0 >= FF, nn = n0 - up * FF, dr = 256 * (nn / 128) + 128 * up + (nn % 128);
            transpose_item<false>(X.w_gu + (size_t)l * D * NGU, D, NGU, (bf16*)(wl + WS_WGU), dr, 64 * kb, n0, scr, lane, X.norm_ffn + l * D); continue; } r -= I_GU;
        { const int nb = D / 32, kb = r / nb, n0 = 32 * (r % nb); transpose_item<false>(X.w_down + (size_t)l * FF * D, FF, D, (bf16*)(wl + WS_WDN), n0, 64 * kb, n0, scr, lane, nullptr); }
    }
}
__device__ __forceinline__ void rows_bf16_ssq(const float* x, bf16* ob, unsigned long long* ssq, int gwb, int ngw) {
    int tid_ = threadIdx.x; asm volatile("" : "+v"(tid_)); const int lane = tid_ & 63, gw = gwb + __builtin_amdgcn_readfirstlane(tid_ >> 6);
    for (int m = gw; m < M; m += ngw) {
        const f32x4* xr = (const f32x4*)(x + (size_t)m * D) + lane; f32x4 v[8]; float s = 0.f;
#pragma unroll
        for (int j = 0; j < 8; ++j) { v[j] = xr[64 * j]; s += (v[j].x * v[j].x + v[j].y * v[j].y) + (v[j].z * v[j].z + v[j].w * v[j].w); }
        s = wave_sum(s);
#pragma unroll
        for (int j = 0; j < 8; ++j) { u32x2 w; w.x = pk2(v[j].x, v[j].y); w.y = pk2(v[j].z, v[j].w); *((u32x2*)(ob + (size_t)m * D) + lane + 64 * j) = w; }
        if (lane == 0) ssq[m] = (unsigned long long)(s * 1048576.0f + 0.5f);
    }
}
__device__ __forceinline__ void rows_final_norm(const bf16* xb, float* out, const float* g, const unsigned long long* ssq, int gwb, int ngw, int nrows) {
    int tid_ = threadIdx.x; asm volatile("" : "+v"(tid_)); const int lane = tid_ & 63, gw = gwb + __builtin_amdgcn_readfirstlane(tid_ >> 6);
    f32x4 gv[8];
#pragma unroll
    for (int j = 0; j < 8; ++j) gv[j] = *((const f32x4*)g + lane + 64 * j);
    for (int m = gw; m < nrows; m += ngw) {
        const u32x2* xr = (const u32x2*)(xb + (size_t)m * D) + lane; f32x4* orow = (f32x4*)(out + (size_t)m * D) + lane; const float rstd = 1.0f / sqrtf((float)ssq[m] * (1.0f / 1048576.0f) * (1.0f / D) + EPS);
        u32x2 w[8];
#pragma unroll
        for (int j = 0; j < 8; ++j) w[j] = xr[64 * j];
#pragma unroll
        for (int j = 0; j < 8; ++j) { const f32x4 v = (f32x4){lo16(w[j].x), hi16(w[j].x), lo16(w[j].y), hi16(w[j].y)}; __builtin_nontemporal_store(v * rstd * gv[j], orow + 64 * j); }
    }
}

__device__ __forceinline__ void prepass_item(const Ctx& X, int l, int item, LAS unsigned char* lds) {
    int tid_ = threadIdx.x; asm volatile("" : "+v"(tid_)); const int tid = tid_, lane = tid & 63, wid = tid >> 6;
    const int b = item >> 5, c = item & 31; const size_t row0 = (size_t)b * SEQ + c * 64;
    LAS float* ga = (LAS float*)lds;
    LAS float* ea = (LAS float*)(lds + 4096);
    constexpr int TOFF = 8192, RP = 1552;
    const bf16* proj = X.proj;
    u32x4 ta[12], tb[13];
#pragma unroll
    for (int j = 0; j < 12; ++j) { const int p = tid + 512 * j, row = p / 96, pc = p % 96; ta[j] = *(const u32x4*)(proj + (row0 + row) * PP + GQ + pc * 8); }
#pragma unroll
    for (int j = 0; j < 13; ++j) { const int p = tid + 512 * j, row = p / 96, pc = p % 96; tb[j] = (u32x4){0u, 0u, 0u, 0u};
        if (p < 67 * 96 && (c > 0 || row >= 3)) tb[j] = *(const u32x4*)(proj + (row0 + row - 3) * PP + MQ + pc * 8); }
    if (wid < 4) {
        const int h = wid; const size_t r = row0 + lane;
        const float ip = bf2f(proj[r * PP + MI + h]) + X.ml_ib[l * 4 + h];
        const float lf = logsig(bf2f(proj[r * PP + MF + h]) + X.ml_fb[l * 4 + h]);
        float cum = lf;
#pragma unroll
        for (int o = 1; o < 64; o <<= 1) { const float v = __shfl_up(cum, o); if (lane >= o) cum += v; }
        const float a = ip - cum; float pm = a;
#pragma unroll
        for (int o = 1; o < 64; o <<= 1) { const float v = __shfl_up(pm, o); if (lane >= o) pm = fmaxf(pm, v); }
        X.cumf[r * 4 + h] = cum; X.pmx[r * 4 + h] = pm; ea[lane * 4 + h] = __expf(a);
    } else {
        const int i = tid - 256;
#pragma unroll
        for (int k = 0; k < 4; ++k) { const int e = i + 256 * k, t = e >> 4, rr = e & 15; ga[e] = bf2f(proj[(row0 + t) * PP + GA1 + rr]); }
    }
#pragma unroll
    for (int j = 0; j < 12; ++j) { const int p = tid + 512 * j, row = p / 96, pc = p % 96; *(LAS u32x4*)(lds + TOFF + row * RP + pc * 16) = ta[j]; }
    __syncthreads();
    if (tid < 384) {
        const int col = tid; float a2r[16];
#pragma unroll
        for (int r = 0; r < 16; ++r) a2r[r] = X.gla_a2[(size_t)(l * 16 + r) * 384 + col];
        const float ab = X.gla_ab[l * 384 + col]; float cum = 0.f;
        LAS unsigned short* qc = (LAS unsigned short*)(lds + TOFF + col * 2); LAS unsigned short* kc = (LAS unsigned short*)(lds + TOFF + (384 + col) * 2);
#pragma unroll 4
        for (int t = 0; t < 64; ++t) {
            float z = ab;
#pragma unroll
            for (int r = 0; r < 16; ++r) z += ga[t * 16 + r] * a2r[r];
            cum += logsig_fast(z) * (1.0f / 16.0f);
            const float e = __expf(cum), ei = __expf(-cum);
            const float q = bf2f(qc[t * (RP / 2)]), kk = bf2f(kc[t * (RP / 2)]);
            qc[t * (RP / 2)] = (unsigned short)f2bf(q * e * QK_SCALE); kc[t * (RP / 2)] = (unsigned short)f2bf(kk * ei);
        }
        X.elast[(size_t)(b * 32 + c) * 384 + col] = __expf(cum);
    }
    __syncthreads();
#pragma unroll
    for (int j = 0; j < 12; ++j) { const int p = tid + 512 * j, row = p / 96, pc = p % 96; const u32x4 v = *(const LAS u32x4*)(lds + TOFF + row * RP + pc * 16);
        bf16* dstp = (pc >= 48 ? X.kg : X.qg) + (row0 + row) * 384 + (pc % 48) * 8; *(u32x4*)dstp = v; }
    __syncthreads();
#pragma unroll
    for (int j = 0; j < 13; ++j) { const int p = tid + 512 * j, row = p / 96, pc = p % 96; if (p < 67 * 96) *(LAS u32x4*)(lds + TOFF + row * RP + pc * 16) = tb[j]; }
    __syncthreads();
    for (int cc = tid; cc < 768; cc += NT) {
        const float w0 = X.ml_conv[(size_t)(l * 4 + 0) * 768 + cc], w1 = X.ml_conv[(size_t)(l * 4 + 1) * 768 + cc], w2 = X.ml_conv[(size_t)(l * 4 + 2) * 768 + cc], w3 = X.ml_conv[(size_t)(l * 4 + 3) * 768 + cc];
        LAS unsigned short* xc_ = (LAS unsigned short*)(lds + TOFF + cc * 2);
        float x3 = bf2f(xc_[0]), x2 = bf2f(xc_[RP / 2]), x1 = bf2f(xc_[2 * (RP / 2)]);
        const bool isk = cc >= 384; const int hh = isk ? (cc - 384) / 96 : 0;
#pragma unroll 4
        for (int t = 0; t < 64; ++t) {
            const float xc = bf2f(xc_[(t + 3) * (RP / 2)]);
            const float y = w0 * x3 + w1 * x2 + w2 * x1 + w3 * xc; float s = y * sigmoidf_(y);
            if (isk) s *= QK_SCALE * ea[t * 4 + hh];
            xc_[(t + 3) * (RP / 2)] = (unsigned short)f2bf(s); x3 = x2; x2 = x1; x1 = xc;
        }
    }
    __syncthreads();
#pragma unroll
    for (int j = 0; j < 12; ++j) { const int p = tid + 512 * j, row = p / 96, pc = p % 96; const u32x4 v = *(const LAS u32x4*)(lds + TOFF + (row + 3) * RP + pc * 16);
        bf16* dstp = (pc >= 48 ? X.km : X.qm) + (row0 + row) * 384 + (pc % 48) * 8; *(u32x4*)dstp = v; }
    __syncthreads();
}

constexpr int SC_QS = 0, SC_KS = 13312, SC_VS = 26624, SC_PS = 54272, SC_ST = 63488, SC_RED = 106752, SC_DEN = 107776, SC_GT = 108032, SC_GN = 108544;
constexpr int QP = 208, VP = 432, PPI = 144, STP = 208;
template <bool ML> __device__ __forceinline__ void scan_item(const Ctx& X, int l, int b, int h, LAS unsigned char* lds) {
    int tid_ = threadIdx.x; asm volatile("" : "+v"(tid_)); const int tid = tid_, lane = tid & 63, wid = __builtin_amdgcn_readfirstlane(tid >> 6);
    const int wh = wid >> 2, wq = wid & 3;
#define LANEV int ln_ = lane; asm volatile("" : "+v"(ln_)); const int r = ln_ & 15, g = ln_ >> 4, q4 = (ln_ & 15) >> 2, p4 = ln_ & 3; (void)r; (void)g; (void)q4; (void)p4;
    const bool v4 = ML && (wq == 3);
    const bf16* qsrc = (ML ? X.qm : X.qg) + h * 96; const bf16* ksrc = (ML ? X.km : X.kg) + h * 96;
    const bf16* vsrc = X.proj + (ML ? MV : GV) + h * 192; const bf16* gsrc = X.proj + (ML ? MO : GG) + h * 192;
    bf16* dst = X.mix + (ML ? 768 : 0) + h * 192;
    const size_t rowb = (size_t)b * SEQ;
    unsigned z_ = 0u, one_ = ML ? 0x00003F80u : 0u; asm volatile("" : "+v"(z_), "+v"(one_));
    for (int i = tid; i < (208 * STP) / 16; i += NT) *(LAS u32x4*)(lds + SC_ST + i * 16) = (u32x4){z_, z_, z_, z_};
    if (tid < 64) { LAS unsigned* vp = (LAS unsigned*)(lds + SC_VS + tid * VP + 384);
#pragma unroll
        for (int i = 0; i < 8; ++i) vp[i] = (i == 0) ? one_ : z_; }
#define STG_OFFS int t_ = tid; asm volatile("" : "+v"(t_)); const int qr_ = t_ >> 4, qc_ = t_ & 15, vr_ = t_ >> 5, vc_ = t_ & 31; const bool qok_ = qc_ < 12, vok_ = vc_ < 24; \
        const unsigned qoff = (unsigned)(qr_ * 384 + qc_ * 8), qlds = (unsigned)(qr_ * QP + qc_ * 16), voff = (unsigned)(vr_ * PP + vc_ * 8), vlds = (unsigned)(vr_ * VP + vc_ * 16); \
        (void)qoff; (void)qlds; (void)voff; (void)vlds; (void)qok_; (void)vok_;
    u32x4 sq[2], sk[2], sv[4]; f32x4 sg = (f32x4){0.f, 0.f, 0.f, 0.f};
#pragma unroll
    for (int p = 0; p < 2; ++p) { sq[p] = (u32x4){0u, 0u, 0u, 0u}; sk[p] = sq[p]; }
#pragma unroll
    for (int p = 0; p < 4; ++p) sv[p] = (u32x4){0u, 0u, 0u, 0u};
#define SC_LOAD(c_) do { STG_OFFS const size_t rb_ = rowb + (size_t)(c_) * 64; const bf16* qb_ = qsrc + rb_ * 384; const bf16* kb_ = ksrc + rb_ * 384; const bf16* vb_ = vsrc + rb_ * PP; \
        if (qok_) { _Pragma("unroll") for (int p = 0; p < 2; ++p) { sq[p] = *(const u32x4*)(qb_ + qoff + p * (32 * 384)); sk[p] = *(const u32x4*)(kb_ + qoff + p * (32 * 384)); } } \
        if (vok_) { _Pragma("unroll") for (int p = 0; p < 4; ++p) sv[p] = *(const u32x4*)(vb_ + voff + p * (16 * PP)); } \
        if (ML) { if (tid < 64) { sg.x = X.pmx[(rb_ + tid) * 4 + h]; sg.y = X.cumf[(rb_ + tid) * 4 + h]; } } \
        else { if (tid < 24) sg = *(const f32x4*)(X.elast + (size_t)(b * 32 + (c_)) * 384 + h * 96 + 4 * tid); } } while (0)
#define SC_STORE() do { STG_OFFS \
        if (qok_) { _Pragma("unroll") for (int p = 0; p < 2; ++p) { *(LAS u32x4*)(lds + SC_QS + qlds + p * (32 * QP)) = sq[p]; *(LAS u32x4*)(lds + SC_KS + qlds + p * (32 * QP)) = sk[p]; } } \
        if (vok_) { _Pragma("unroll") for (int p = 0; p < 4; ++p) *(LAS u32x4*)(lds + SC_VS + vlds + p * (16 * VP)) = sv[p]; } \
        if (ML) { if (tid < 64) { *(LAS float*)(lds + SC_GT + tid * 4) = sg.x; *(LAS float*)(lds + SC_GT + 256 + tid * 4) = sg.y; } } \
        else { if (tid < 24) *(LAS f32x4*)(lds + SC_GT + tid * 16) = sg; } } while (0)
#define GT_PM(t_) (*(const LAS float*)(lds + SC_GT + (t_) * 4))
#define GT_CUM(t_) (*(const LAS float*)(lds + SC_GT + 256 + (t_) * 4))
    SC_LOAD(0); SC_STORE();
    f32x4 sacc[3][4];
#pragma unroll
    for (int i = 0; i < 3; ++i)
#pragma unroll
        for (int j = 0; j < 4; ++j) sacc[i][j] = (f32x4){0.f, 0.f, 0.f, 0.f};
    float m_st = 0.f;
    const int tb1 = wid >> 1;
    __syncthreads();
    for (int c = 0; c < 32; ++c) {
        const size_t rbc = rowb + (size_t)c * 64;
        if (c + 1 < 32) { SC_LOAD(c + 1); }
        float pm63 = 0.f, cum63 = 0.f, pmt[2] = {0.f, 0.f}, cumt[2] = {0.f, 0.f};
        if (ML) { LANEV pm63 = GT_PM(63); cum63 = GT_CUM(63);
#pragma unroll
            for (int ti = 0; ti < 2; ++ti) { pmt[ti] = GT_PM(16 * (2 * wh + ti) + r); cumt[ti] = GT_CUM(16 * (2 * wh + ti) + r); } }
        u32x2 gate[2][3];
        { LANEV const bf16* gb_ = gsrc + rbc * PP;
#pragma unroll
        for (int ti = 0; ti < 2; ++ti)
#pragma unroll
            for (int vi = 0; vi < 3; ++vi) gate[ti][vi] = *(const u32x2*)(gb_ + (unsigned)((16 * (2 * wh + ti) + r) * PP + 16 * (3 * wq + vi) + 4 * g)); }
        {
            LANEV bf16x8 qf[3], kf[2][3];
#pragma unroll
            for (int ds = 0; ds < 3; ++ds) qf[ds] = ld128(lds + SC_QS + (16 * tb1 + r) * QP + (32 * ds + 8 * g) * 2);
#pragma unroll
            for (int si = 0; si < 2; ++si)
#pragma unroll
                for (int ds = 0; ds < 3; ++ds) kf[si][ds] = ld128(lds + SC_KS + (16 * (2 * (wid & 1) + si) + r) * QP + (32 * ds + 8 * g) * 2);
            __builtin_amdgcn_sched_barrier(0);
#pragma unroll
            for (int si = 0; si < 2; ++si) {
                const int sb = 2 * (wid & 1) + si; f32x4 acc = (f32x4){0.f, 0.f, 0.f, 0.f};
                if (sb <= tb1) {
#pragma unroll
                    for (int ds = 0; ds < 3; ++ds) acc = MFMA16(kf[si][ds], qf[ds], acc);
#pragma unroll
                    for (int j = 0; j < 4; ++j) { const bool keep = (16 * sb + 4 * g + j) <= (16 * tb1 + r); acc[j] = keep ? acc[j] : 0.f; }
                }
                u32x2 w; w.x = pk2(acc[0], acc[1]); w.y = pk2(acc[2], acc[3]);
                *(LAS u32x2*)(lds + SC_PS + (16 * tb1 + r) * PPI + (16 * sb + 4 * g) * 2) = w;
            }
        }
        f32x4 oacc[2][4];
#pragma unroll
        for (int ti = 0; ti < 2; ++ti)
#pragma unroll
            for (int vi = 0; vi < 4; ++vi) oacc[ti][vi] = (f32x4){0.f, 0.f, 0.f, 0.f};
        {
            LANEV bf16x8 qf[2][3];
#pragma unroll
            for (int ti = 0; ti < 2; ++ti)
#pragma unroll
                for (int ds = 0; ds < 3; ++ds) qf[ti][ds] = ld128(lds + SC_QS + (16 * (2 * wh + ti) + r) * QP + (32 * ds + 8 * g) * 2);
#pragma unroll
            for (int vh = 0; vh < 2; ++vh) {
                bf16x8 sf[2][3];
#pragma unroll
                for (int v2 = 0; v2 < 2; ++v2)
#pragma unroll
                    for (int ds = 0; ds < 3; ++ds) { const int vi = 2 * vh + v2;
                        if (vi < 3 || v4) sf[v2][ds] = ld128(lds + SC_ST + (16 * (3 * wq + vi) + r) * STP + (32 * ds + 8 * g) * 2); else sf[v2][ds] = (bf16x8){0, 0, 0, 0, 0, 0, 0, 0}; }
                __builtin_amdgcn_sched_barrier(0);
#pragma unroll
                for (int v2 = 0; v2 < 2; ++v2) { const int vi = 2 * vh + v2;
                    if (vi < 3 || v4) {
#pragma unroll
                        for (int ds = 0; ds < 3; ++ds)
#pragma unroll
                            for (int ti = 0; ti < 2; ++ti) oacc[ti][vi] = MFMA16(sf[v2][ds], qf[ti][ds], oacc[ti][vi]);
                    } }
                __builtin_amdgcn_sched_barrier(0);
            }
        }
        WG_BAR();
        bf16x8 vf[4][2];
        { LANEV
#pragma unroll
        for (int vi = 0; vi < 4; ++vi)
#pragma unroll
            for (int ss = 0; ss < 2; ++ss)
                if (vi < 3 || v4) vf[vi][ss] = vtr2(lds + SC_VS + (32 * ss + 8 * g + q4) * VP + (16 * (3 * wq + vi) + 4 * p4) * 2, 4 * VP);
                else vf[vi][ss] = (bf16x8){0, 0, 0, 0, 0, 0, 0, 0};
        }
        {
            LANEV bf16x8 pf[2][2];
#pragma unroll
            for (int ti = 0; ti < 2; ++ti)
#pragma unroll
                for (int ss = 0; ss < 2; ++ss) pf[ti][ss] = ld128(lds + SC_PS + (16 * (2 * wh + ti) + r) * PPI + (32 * ss + 8 * g) * 2);
            __builtin_amdgcn_sched_barrier(0);
#pragma unroll
            for (int vi = 0; vi < 4; ++vi)
                if (vi < 3 || v4) {
#pragma unroll
                    for (int ti = 0; ti < 2; ++ti)
#pragma unroll
                        for (int ss = 0; ss < 2; ++ss) oacc[ti][vi] = MFMA16(vf[vi][ss], pf[ti][ss], oacc[ti][vi]);
                }
        }
        { LANEV
#pragma unroll
        for (int ti = 0; ti < 2; ++ti) {
            float s = 0.f;
#pragma unroll
            for (int vi = 0; vi < 3; ++vi)
#pragma unroll
                for (int j = 0; j < 4; ++j) s += oacc[ti][vi][j] * oacc[ti][vi][j];
            s += __shfl_xor(s, 16); s += __shfl_xor(s, 32);
            if (g == 0) { *(LAS float*)(lds + SC_RED + ((16 * (2 * wh + ti) + r) * 4 + wq) * 4) = s; if (v4) *(LAS float*)(lds + SC_DEN + (16 * (2 * wh + ti) + r) * 4) = oacc[ti][3][0]; }
        } }
        u32x2 opk[2][3];
#pragma unroll
        for (int ti = 0; ti < 2; ++ti)
#pragma unroll
            for (int vi = 0; vi < 3; ++vi) { opk[ti][vi].x = pk2(oacc[ti][vi][0], oacc[ti][vi][1]); opk[ti][vi].y = pk2(oacc[ti][vi][2], oacc[ti][vi][3]); }
        {
            LANEV const float e_out = ML ? __expf(cum63) : 1.0f;
            bf16x8 kt[3][2];
#pragma unroll
            for (int di = 0; di < 3; ++di)
#pragma unroll
                for (int ss = 0; ss < 2; ++ss) kt[di][ss] = vtr2(lds + SC_KS + (32 * ss + 8 * g + q4) * QP + (16 * (3 * wh + di) + 4 * p4) * 2, 4 * QP);
            __builtin_amdgcn_sched_barrier(0);
#pragma unroll
            for (int di = 0; di < 3; ++di)
#pragma unroll
                for (int vi = 0; vi < 4; ++vi)
                    if (vi < 3 || v4) {
#pragma unroll
                        for (int ss = 0; ss < 2; ++ss) sacc[di][vi] = MFMA16(kt[di][ss], vf[vi][ss], sacc[di][vi]);
                    }
            __builtin_amdgcn_sched_barrier(0);
#pragma unroll
            for (int di = 0; di < 3; ++di) {
                f32x4 dec = (f32x4){e_out, e_out, e_out, e_out};
                if (!ML) dec = *(const LAS f32x4*)(lds + SC_GT + (16 * (3 * wh + di) + 4 * g) * 4);
#pragma unroll
                for (int vi = 0; vi < 4; ++vi)
                    if (vi < 3 || v4) {
                        const f32x4 a = sacc[di][vi] * dec; sacc[di][vi] = a;
                        u32x2 w; w.x = pk2(a[0], a[1]); w.y = pk2(a[2], a[3]);
                        *(LAS u32x2*)(lds + SC_ST + (16 * (3 * wq + vi) + r) * STP + (16 * (3 * wh + di) + 4 * g) * 2) = w;
                    }
            }
        }
        WG_BAR();
        { LANEV
#pragma unroll
        for (int ti = 0; ti < 2; ++ti) {
            const int t = 16 * (2 * wh + ti) + r;
            const f32x4 rp = *(const LAS f32x4*)(lds + SC_RED + t * 16);
            float ssq = (rp.x + rp.y) + (rp.z + rp.w), inv = 1.0f;
            if (ML) { const float Mt = fmaxf(m_st, pmt[ti]), eM = __expf(-Mt); const float den = *(const LAS float*)(lds + SC_DEN + t * 4) * eM;
                const float dn = fmaxf(fabsf(den), __expf(-(cumt[ti] + Mt))); inv = eM / dn; ssq = ssq * inv * inv; }
            const float rstd = inv / sqrtf(ssq * (1.0f / 192.0f) + EPS);
#pragma unroll
            for (int vi = 0; vi < 3; ++vi) {
                const int dv = 16 * (3 * wq + vi) + 4 * g;
                const float a0 = lo16(gate[ti][vi].x) * rstd, a1 = hi16(gate[ti][vi].x) * rstd, a2 = lo16(gate[ti][vi].y) * rstd, a3 = hi16(gate[ti][vi].y) * rstd;
                const f32x4 o = (f32x4){lo16(opk[ti][vi].x), hi16(opk[ti][vi].x), lo16(opk[ti][vi].y), hi16(opk[ti][vi].y)};
                u32x2 w; w.x = pk2(o[0] * a0, o[1] * a1); w.y = pk2(o[2] * a2, o[3] * a3);
                *(u32x2*)(dst + rbc * D + (unsigned)(t * D + dv)) = w;
            }
        } }
        if (ML) m_st = cum63 + fmaxf(m_st, pm63);
        if (c + 1 < 32) SC_STORE();
        WG_BAR();
    }
#undef SC_LOAD
#undef SC_STORE
#undef LANEV
#undef STG_OFFS
#undef GT_PM
#undef GT_CUM
}

constexpr int SG_W = 0, SG_V = 34816, SGP = 272;
__device__ __forceinline__ void sgu_item(const Ctx& X, int l, int item, LAS unsigned char* lds) {
    int tid_ = threadIdx.x; asm volatile("" : "+v"(tid_)); const int tid = tid_, lane = tid & 63, wid = __builtin_amdgcn_readfirstlane(tid >> 6);
    const int r = lane & 15, g = lane >> 4, q4 = (lane & 15) >> 2, p4 = lane & 3;
    const int grp = item & 3, nb = (item >> 2) & 15, b = item >> 6; const size_t row0 = (size_t)b * SEQ + nb * 128;
    u32x4 raw[16];
#pragma unroll
    for (int i = 0; i < 16; ++i) raw[i] = *(const u32x4*)(X.proj + (row0 + wid * 16 + i) * PP + SV + lane * 8);
    float lgv[8], lbv[8];
    { const f32x4 a0 = *(const f32x4*)(X.sgu_ln_g + l * 512 + lane * 8), a1 = *(const f32x4*)(X.sgu_ln_g + l * 512 + lane * 8 + 4), b0 = *(const f32x4*)(X.sgu_ln_b + l * 512 + lane * 8), b1 = *(const f32x4*)(X.sgu_ln_b + l * 512 + lane * 8 + 4);
      lgv[0] = a0.x; lgv[1] = a0.y; lgv[2] = a0.z; lgv[3] = a0.w; lgv[4] = a1.x; lgv[5] = a1.y; lgv[6] = a1.z; lgv[7] = a1.w;
      lbv[0] = b0.x; lbv[1] = b0.y; lbv[2] = b0.z; lbv[3] = b0.w; lbv[4] = b1.x; lbv[5] = b1.y; lbv[6] = b1.z; lbv[7] = b1.w; }
    { const float* wsrc = X.sgu_w + (size_t)(l * 4 + grp) * 16384; f32x4 wv[8];
#pragma unroll
        for (int k = 0; k < 8; ++k) { const int e = tid + 512 * k, t = e >> 5, s0 = (e & 31) * 4; wv[k] = *(const f32x4*)(wsrc + t * 128 + s0); }
#pragma unroll
        for (int k = 0; k < 8; ++k) { const int e = tid + 512 * k, t = e >> 5, s0 = (e & 31) * 4; const f32x4 w = wv[k];
            u32x2 o; o.x = pk2(s0 <= t ? w.x : 0.f, s0 + 1 <= t ? w.y : 0.f); o.y = pk2(s0 + 2 <= t ? w.z : 0.f, s0 + 3 <= t ? w.w : 0.f);
            *(LAS u32x2*)(lds + SG_W + t * SGP + s0 * 2) = o; } }
#pragma unroll
    for (int i = 0; i < 16; ++i) {
        const int s = wid * 16 + i; const u32x4 rw = raw[i];
        float v[8]; v[0] = lo16(rw.x); v[1] = hi16(rw.x); v[2] = lo16(rw.y); v[3] = hi16(rw.y); v[4] = lo16(rw.z); v[5] = hi16(rw.z); v[6] = lo16(rw.w); v[7] = hi16(rw.w);
        float sm = 0.f;
#pragma unroll
        for (int j = 0; j < 8; ++j) sm += v[j];
        const float mu = wave_sum(sm) * (1.0f / 512.0f); float sq = 0.f;
#pragma unroll
        for (int j = 0; j < 8; ++j) { v[j] -= mu; sq += v[j] * v[j]; }
        const float rstd = 1.0f / sqrtf(wave_sum(sq) * (1.0f / 512.0f) + EPS);
        if ((lane >> 4) == grp) { float y[8];
#pragma unroll
            for (int j = 0; j < 8; ++j) y[j] = v[j] * rstd * lgv[j] + lbv[j];
            u32x4 o; o.x = pk2(y[0], y[1]); o.y = pk2(y[2], y[3]); o.z = pk2(y[4], y[5]); o.w = pk2(y[6], y[7]);
            *(LAS u32x4*)(lds + SG_V + s * SGP + (lane & 15) * 16) = o; }
    }
    __syncthreads();
    {
        const int tb = wid; f32x4 acc[8];
        const int t = 16 * tb + r; const float bs = X.sgu_b[(size_t)(l * 4 + grp) * 128 + t];
        u32x2 suv[8];
#pragma unroll
        for (int cb = 0; cb < 8; ++cb) suv[cb] = *(const u32x2*)(X.proj + (row0 + t) * PP + SU + grp * 128 + 16 * cb + 4 * g);
#pragma unroll
        for (int cb = 0; cb < 8; ++cb) acc[cb] = (f32x4){0.f, 0.f, 0.f, 0.f};
#pragma unroll
        for (int ks = 0; ks < 4; ++ks) {
            if (32 * ks <= 16 * tb + 15) {
                const bf16x8 wf = ld128(lds + SG_W + (16 * tb + r) * SGP + (32 * ks + 8 * g) * 2); bf16x8 vfr[8];
#pragma unroll
                for (int cb = 0; cb < 8; ++cb) vfr[cb] = vtr2(lds + SG_V + (32 * ks + 8 * g + q4) * SGP + (16 * cb + 4 * p4) * 2, 4 * SGP);
                __builtin_amdgcn_sched_barrier(0);
#pragma unroll
                for (int cb = 0; cb < 8; ++cb) acc[cb] = MFMA16(vfr[cb], wf, acc[cb]);
                __builtin_amdgcn_sched_barrier(0);
            }
        }
#pragma unroll
        for (int cb = 0; cb < 8; ++cb) { const int ch = grp * 128 + 16 * cb + 4 * g; const u32x2 su = suv[cb];
            const float u0 = lo16(su.x), u1 = hi16(su.x), u2 = lo16(su.y), u3 = hi16(su.y);
            u32x2 w; w.x = pk2(u0 * (acc[cb][0] + bs), u1 * (acc[cb][1] + bs)); w.y = pk2(u2 * (acc[cb][2] + bs), u3 * (acc[cb][3] + bs));
            *(u32x2*)(X.mix + (row0 + t) * D + 1536 + ch) = w; }
    }
    __syncthreads();
}

#define XB_TMO      128
#define XB_XCNT(j)  (256  + 64 * (j))
#define XB_XSUB(j)  (1280 + 64 * (j))
#define XB_XGEN(j)  (2304 + 64 * (j))
#define XB_TOP      3328
#define XB_TOPGEN   3392
#define XCD_BAR_WORDS 3456
#define XB_SPIN_CAP (1u << 18)

__device__ __forceinline__ unsigned xb_ld(unsigned* p)              { return __hip_atomic_load(p, __ATOMIC_RELAXED, __HIP_MEMORY_SCOPE_AGENT); }
__device__ __forceinline__ unsigned xb_add(unsigned* p, unsigned v) { return __hip_atomic_fetch_add(p, v, __ATOMIC_RELAXED, __HIP_MEMORY_SCOPE_AGENT); }
__device__ __forceinline__ unsigned xb_xcc_id() { return (unsigned)__builtin_amdgcn_s_getreg((3 << 11) | 20) & 0xFu; }
#define XB_SPIN(cond, bar) do { unsigned _sp = 0; while (cond) { __builtin_amdgcn_s_sleep(1); \
    if ((++_sp & 255u) == 0u) { if (xb_ld(&(bar)[XB_TMO])) break; if (_sp > XB_SPIN_CAP) { atomicAdd(&(bar)[XB_TMO], 1u); break; } } } } while (0)

struct XcdBarrier {
    unsigned* bar; unsigned x;
    volatile LAS unsigned* st;
};

__device__ __forceinline__ XcdBarrier xcd_barrier_post(unsigned* bar, volatile LAS unsigned* st) {
    XcdBarrier b; b.bar = bar; b.x = xb_xcc_id(); b.st = st;
    if (threadIdx.x == 0) (void)xb_add(&bar[XB_XCNT(b.x)], 1u);
    return b;
}
__device__ __forceinline__ void xcd_barrier_complete(unsigned* bar, unsigned x, unsigned& nloc, unsigned& nx) {
    const unsigned G = gridDim.x * gridDim.y * gridDim.z;
    unsigned sum, cnt, mine, sp = 0u;
    for (;;) {
        sum = 0u; cnt = 0u; mine = 0u;
#pragma unroll
        for (unsigned j = 0; j < 16; ++j) { const unsigned c = xb_ld(&bar[XB_XCNT(j)]); sum += c; cnt += (c > 0u) ? 1u : 0u; mine = (j == x) ? c : mine; }
        if (sum == G) break;
        __builtin_amdgcn_s_sleep(1);
        if ((++sp & 255u) == 0u) { if (xb_ld(&bar[XB_TMO])) break; if (sp > XB_SPIN_CAP) { atomicAdd(&bar[XB_TMO], 1u); break; } }
    }
    nloc = mine > 0u ? mine : 1u; nx = cnt > 0u ? cnt : 1u;
}

__device__ __forceinline__ void xcd_barrier(const XcdBarrier& b, const bool glob = true) {
    asm volatile("s_waitcnt vmcnt(0)" ::: "memory");
    __syncthreads();
    if (threadIdx.x == 0) {
        unsigned* bar = b.bar;
        __builtin_amdgcn_s_waitcnt(0);
        unsigned nloc = b.st[0], nx = b.st[1];
        if (nloc == 0u) { xcd_barrier_complete(bar, b.x, nloc, nx); b.st[0] = nloc; b.st[1] = nx; }
        const unsigned old = xb_add(&bar[XB_XSUB(b.x)], 1u);
        const unsigned gen = old / nloc;
        if (old + 1u == (gen + 1u) * nloc) {
            if (glob) {
            __builtin_amdgcn_fence(__ATOMIC_RELEASE, "agent");
            asm volatile("s_waitcnt vmcnt(0)" ::: "memory");
            const unsigned og = xb_add(&bar[XB_TOP], 1u);
            const unsigned tg = og / nx;
            if (og + 1u == (tg + 1u) * nx) xb_add(&bar[XB_TOPGEN], 1u);
            else XB_SPIN(xb_ld(&bar[XB_TOPGEN]) == tg, bar);
            }
            __builtin_amdgcn_fence(__ATOMIC_ACQUIRE, "agent");
            xb_add(&bar[XB_XGEN(b.x)], 1u);
            asm volatile("s_waitcnt vmcnt(0)" ::: "memory");
        } else {
            XB_SPIN(xb_ld(&bar[XB_XGEN(b.x)]) == gen, bar);
            __builtin_amdgcn_fence(__ATOMIC_ACQUIRE, "agent");
            asm volatile("s_waitcnt vmcnt(0)" ::: "memory");
        }
    }
    __syncthreads();
}

#ifndef DIS_PRO
#define DIS_PRO 0
#endif
#ifndef DIS_G0
#define DIS_G0 0
#endif
#ifndef DIS_PRE
#define DIS_PRE 0
#endif
#ifndef DIS_SCAN
#define DIS_SCAN 0
#endif
#ifndef DIS_SGU
#define DIS_SGU 0
#endif
#ifndef DIS_G3
#define DIS_G3 0
#endif
#ifndef DIS_G5
#define DIS_G5 0
#endif
#ifndef DIS_G6
#define DIS_G6 0
#endif
#ifndef GRID_SYNC
#define GRID_SYNC() cg::this_grid().sync()
#endif
#ifndef DIS_NORM
#define DIS_NORM 0
#endif
#ifndef REP_SCAN
#define REP_SCAN 1
#endif
#ifndef REP_PRE
#define REP_PRE 1
#endif
#ifndef REP_PRO
#define REP_PRO 1
#endif
#ifndef REP_G0
#define REP_G0 1
#endif
#ifndef REP_G5
#define REP_G5 1
#endif
#ifndef REP_NORM
#define REP_NORM 1
#endif
#ifndef REP_SGU
#define REP_SGU 1
#endif
#ifndef REP_G3
#define REP_G3 1
#endif
struct Args { const float* in[19]; float* out; unsigned char* ws; int ph_lo, ph_hi; };
constexpr int N_PHASES = 2 + 6 * NL;
__global__ void __launch_bounds__(NT, 2) hymba_fwd(Args args) {
    extern __shared__ __attribute__((aligned(16))) unsigned char lds_raw[];
    LAS unsigned char* lds = (LAS unsigned char*)lds_raw;
    Ctx X;
    X.x = args.in[0]; X.norm_mix = args.in[1]; X.w_in = args.in[2]; X.gla_a2 = args.in[3]; X.gla_ab = args.in[4]; X.gla_norm = args.in[5]; X.ml_conv = args.in[6]; X.ml_ib = args.in[7];
    X.ml_fb = args.in[8]; X.ml_norm = args.in[9]; X.sgu_ln_g = args.in[10]; X.sgu_ln_b = args.in[11]; X.sgu_w = args.in[12]; X.sgu_b = args.in[13]; X.w_out = args.in[14]; X.norm_ffn = args.in[15];
    X.w_gu = args.in[16]; X.w_down = args.in[17]; X.norm_final = args.in[18]; X.out = args.out; X.ws = args.ws;
    X.xn = (bf16*)(args.ws + WS_XN); X.proj = (bf16*)(args.ws + WS_PROJ); X.act = (bf16*)(args.ws + WS_PROJ); X.mix = (bf16*)(args.ws + WS_MIX);
    X.qg = (bf16*)(args.ws + WS_QG); X.kg = (bf16*)(args.ws + WS_KG); X.qm = (bf16*)(args.ws + WS_QM); X.km = (bf16*)(args.ws + WS_KM);
    X.elast = (float*)(args.ws + WS_ELAST); X.cumf = (float*)(args.ws + WS_CUMF); X.pmx = (float*)(args.ws + WS_PMX);
    const int G = gridDim.x, bx = blockIdx.x, ngw = G * NWAVES;
    const int lo = args.ph_lo, hi = args.ph_hi;
#define IN(k) (lo <= (k) && (k) < hi)
    if (threadIdx.x < 16) ((LAS unsigned*)(lds + LDS_CTL_OFF))[threadIdx.x] = 0u;
    __syncthreads();
    const XcdBarrier xbar = xcd_barrier_post((unsigned*)(args.ws + WS_CTL), (volatile LAS unsigned*)(lds + LDS_CTL_OFF));
    if (threadIdx.x == 0) { unsigned* ctl_ = (unsigned*)(args.ws + WS_CTL); const unsigned x_ = xb_xcc_id();
        const unsigned rk_ = __hip_atomic_fetch_add(ctl_ + 3584 + x_, 1u, __ATOMIC_RELAXED, __HIP_MEMORY_SCOPE_AGENT);
        if (rk_ >= 32u || x_ >= 8u || G != 256) __hip_atomic_store(ctl_ + 3616, 1u, __ATOMIC_RELAXED, __HIP_MEMORY_SCOPE_AGENT);
        ((volatile LAS unsigned*)(lds + LDS_CTL_OFF))[4] = rk_ * 8u + x_; }
#define SEAM(k) do { if (IN(k) && IN((k) + 1)) { if ((k) == 0) GRID_SYNC(); else xcd_barrier(xbar); } } while (0)
#define SEAML(k) do { if (IN(k) && IN((k) + 1)) xcd_barrier(xbar, !xloc); } while (0)
    unsigned long long* ssq = (unsigned long long*)(args.ws + WS_SSQ);
    if (IN(0) && !DIS_PRO) for (int rep_ = 0; rep_ < REP_PRO; ++rep_) {
        for (int i = bx * NT + (int)threadIdx.x; i < 4 * M; i += G * NT) ssq[M + i] = 0ull;
        convert_weights(X, lds, bx * NWAVES, ngw, 0, I_IN + I_OUT + I_GU); rows_bf16_ssq(X.x, X.xn, ssq, bx * NWAVES, ngw); }
    SEAM(0);
    int cx = bx;
    { const unsigned bad_ = __hip_atomic_load((unsigned*)(args.ws + WS_CTL) + 3616, __ATOMIC_RELAXED, __HIP_MEMORY_SCOPE_AGENT);
      const int c_ = (int)((volatile LAS unsigned*)(lds + LDS_CTL_OFF))[4]; if (!bad_) cx = __builtin_amdgcn_readfirstlane(c_); }
    const bool xloc = (cx != bx) || (G == 256 && __hip_atomic_load((unsigned*)(args.ws + WS_CTL) + 3616, __ATOMIC_RELAXED, __HIP_MEMORY_SCOPE_AGENT) == 0u);
    const int xb_ = cx & 7, xj_ = cx >> 3;
    for (int l = 0; l < NL; ++l) {
        const int pb = 1 + 6 * l; unsigned char* wl = args.ws + (size_t)l * WS_LAYER;
        const float* xin = (l == 0) ? X.x : X.out;
        if (IN(pb + 0) && !DIS_G0) for (int rep_ = 0; rep_ < REP_G0; ++rep_) { pg8::Gemm gm{X.xn, (const bf16*)(wl + WS_WIN), M, PP, D}; pg8::StaticOrder S; S.init(M, PP, G, cx);
            pg8::EpiProj E{X.proj, PP, X.gla_norm + l * 768, X.ml_norm + l * 768, ssq + (size_t)(2 * l) * M, 1.0f / D, EPS};
            pg8::gemm_phase<pg8::EpiProj, pg8::StaticOrder, true, true>(lds, gm, S, E); }
        SEAML(pb + 0);
        if (IN(pb + 1) && !DIS_PRE) for (int rep_ = 0; rep_ < REP_PRE; ++rep_) { if (xloc) prepass_item(X, l, xb_ * 32 + xj_, lds); else for (int it = bx; it < 256; it += G) prepass_item(X, l, it, lds); }
        SEAML(pb + 1);
        if (IN(pb + 2)) for (int rep_ = 0; rep_ < REP_SCAN; ++rep_) {
            if (xloc) {
                if (xj_ < 8) { if (xj_ & 1) scan_item<true>(X, l, xb_, xj_ >> 1, lds); else scan_item<false>(X, l, xb_, xj_ >> 1, lds); }
                else { for (int it = xj_ - 8; it < 64; it += 24) sgu_item(X, l, xb_ * 64 + it, lds);
                    if (rep_ == 0) convert_weights(X, lds, (xb_ * 24 + xj_ - 8) * NWAVES, 192 * NWAVES, l == 0 ? I_IN + I_OUT + I_GU : I_L + I_IN + I_OUT, l == 0 ? I_L + I_IN + I_OUT : 2 * I_L); }
            } else {
            if (DIS_SCAN) {} else if (bx < 64) { if (bx & 1) scan_item<true>(X, l, bx >> 3, (bx >> 1) & 3, lds); else scan_item<false>(X, l, bx >> 3, (bx >> 1) & 3, lds); }
            else if (!DIS_SGU) for (int rs_ = 0; rs_ < REP_SGU; ++rs_) { for (int it = bx - 64; it < 512; it += G - 64) sgu_item(X, l, it, lds); }
            if (bx >= 64 && rep_ == 0) convert_weights(X, lds, (bx - 64) * NWAVES, (G - 64) * NWAVES, l == 0 ? I_IN + I_OUT + I_GU : I_L + I_IN + I_OUT, l == 0 ? I_L + I_IN + I_OUT : 2 * I_L);
            }
        }
        SEAM(pb + 2);
        if (IN(pb + 3) && !DIS_G3) { pg8::Gemm gm{X.mix, (const bf16*)(wl + WS_WOUT), M, D, D}; pg8::StaticOrder S; S.init(M, D, G, cx); pg8::EpiResid E{nullptr, nullptr, D, X.xn, ssq + (size_t)(2 * l + 1) * M};
            pg8::gemm_phase<pg8::EpiResid, pg8::StaticOrder, true, true>(lds, gm, S, E); }
        SEAML(pb + 3);
        if (IN(pb + 4) && !DIS_G5) for (int rep_ = 0; rep_ < REP_G5; ++rep_) { pg8::Gemm gm{X.xn, (const bf16*)(wl + WS_WGU), M, NGU, D}; pg8::StaticOrder S; S.init(M, NGU, G, cx);
            pg8::EpiSwiGLU E{X.act, FF, ssq + (size_t)(2 * l + 1) * M, 1.0f / D, EPS};
            pg8::gemm_phase<pg8::EpiSwiGLU, pg8::StaticOrder, true, true>(lds, gm, S, E); }
        SEAML(pb + 4);
        if (IN(pb + 5) && !DIS_G6) { pg8::Gemm gm{X.act, (const bf16*)(wl + WS_WDN), M, D, FF}; pg8::StaticOrder S; S.init(M, D, G, cx); pg8::EpiResid E{nullptr, nullptr, D, X.xn, ssq + (size_t)(2 * l + 2) * M};
            pg8::gemm_phase<pg8::EpiResid, pg8::StaticOrder, true, true>(lds, gm, S, E); }
        if (l + 1 < NL) SEAM(pb + 5); else SEAML(pb + 5);
    }
    if (IN(1 + 6 * NL) && !DIS_NORM) {
        if (xloc) { const size_t r0 = (size_t)xb_ * SEQ;
            rows_final_norm(X.xn + r0 * D, X.out + r0 * D, X.norm_final, ssq + (size_t)4 * M + r0, xj_ * NWAVES, 32 * NWAVES, SEQ); }
        else rows_final_norm(X.xn, X.out, X.norm_final, ssq + (size_t)4 * M, bx * NWAVES, ngw, M);
    }
#undef IN
#undef SEAM
}

#ifndef MK_ONE_LAUNCH
#define MK_ONE_LAUNCH 1
#endif
extern "C" void kernel_launch(void* const* d_in, const int* in_sizes, int n_in, void* d_out, int out_size, void* d_ws, size_t ws_size, hipStream_t stream) {
    static int grid = 0;
    if (grid == 0) {
        if (n_in != 19 || out_size != M * D || ws_size < WS_END) { fprintf(stderr, "kernel_launch: unexpected shapes (n_in %d out %d ws %zu)\n", n_in, out_size, ws_size); grid = -1; return; }
        int dev = 0, cus = 0, per_cu = 0;
        hipGetDevice(&dev); hipDeviceGetAttribute(&cus, hipDeviceAttributeMultiprocessorCount, dev);
        if (hipFuncSetAttribute((const void*)hymba_fwd, hipFuncAttributeMaxDynamicSharedMemorySize, LDS_BYTES) != hipSuccess) { fprintf(stderr, "kernel_launch: hipFuncSetAttribute failed\n"); grid = -1; return; }
        if (hipOccupancyMaxActiveBlocksPerMultiprocessor(&per_cu, (const void*)hymba_fwd, NT, LDS_BYTES) != hipSuccess || per_cu < 1) { fprintf(stderr, "kernel_launch: occupancy query gave %d\n", per_cu); per_cu = 1; }
        (void)hipGetLastError();
        grid = cus * 1;
        if (grid > cus * per_cu) grid = cus * per_cu;
    }
    if (grid < 0) return;
    if (hipMemsetAsync((char*)d_ws + WS_CTL, 0, CTL_BYTES, stream) != hipSuccess) { fprintf(stderr, "kernel_launch: memset failed\n"); return; }
    Args a{};
    for (int i = 0; i < 19; ++i) a.in[i] = (const float*)d_in[i];
    a.out = (float*)d_out; a.ws = (unsigned char*)d_ws;
#if MK_ONE_LAUNCH
    a.ph_lo = 0; a.ph_hi = N_PHASES;
    void* kargs[] = {&a};
    hipError_t e = hipLaunchCooperativeKernel((const void*)hymba_fwd, dim3(grid), dim3(NT), kargs, LDS_BYTES, stream);
    if (e != hipSuccess) fprintf(stderr, "kernel_launch: cooperative launch failed: %s (grid %d)\n", hipGetErrorString(e), grid);
#else
    for (int p = 0; p < N_PHASES; ++p) { a.ph_lo = p; a.ph_hi = p + 1; hipLaunchKernelGGL(hymba_fwd, dim3(grid), dim3(NT), LDS_BYTES, stream, a); }
#endif
}
```

```cpp
#include <hip/hip_runtime.h>
#include <hip/hip_cooperative_groups.h>
#include <cstdio>
#include <cstdint>
namespace cg = cooperative_groups;
namespace pg8 {
#define PG8_LAS __attribute__((address_space(3)))
typedef unsigned short bf16_t;
typedef short bf16x8 __attribute__((ext_vector_type(8)));
typedef float f32x4 __attribute__((ext_vector_type(4)));
typedef unsigned u32x4 __attribute__((ext_vector_type(4)));
constexpr int BM = 256, BK = 64, HALF = 128, HTB = HALF * BK * 2  , STAGE_BYTES = 8 * HTB, NXCD = 8, WGM = 8;

__host__ __device__ __forceinline__ int lds_byte(int r, int c) { const int st = (r >> 4) * 2 + (c >> 5), rr = r & 15, cc = c & 31, ob = rr * 64 + cc * 2; return st * 1024 + (ob ^ (((ob >> 9) & 1) << 5)); }
__host__ __device__ __forceinline__ void stage_rc(int b, int& R, int& C) { const int st = b / 1024, sb = b % 1024, swz = sb ^ (((sb >> 9) & 1) << 5); R = (st >> 1) * 16 + swz / 64; C = (st & 1) * 32 + (swz % 64) / 2; }
__host__ __device__ __forceinline__ int perm32(int rho) { const int n = rho >> 4, i = rho & 15; return 8 * (i >> 2) + 4 * n + (i & 3); }

struct Unit { int pm, pn; };
struct Gemm { const bf16_t* A; const bf16_t* Bt; int M, N, K; };

struct StaticOrder {
    int nM, nN, nwg, G, c;
    __host__ __device__ void init(int M, int N, int G_, int c_) { nM = M / BM; nN = N / BM; nwg = nM * nN; G = G_; c = c_; }
    __host__ __device__ bool next(int i, Unit& u) const {
        const long L = (long)i * G + c; if (L >= nwg) return false;
        int wgid = (int)L; { const int q = nwg / NXCD, r = nwg % NXCD, xcd = wgid % NXCD, off = wgid / NXCD; wgid = (xcd < r ? xcd * (q + 1) : r * (q + 1) + (xcd - r) * q) + off; }
        const int nig = WGM * nN, gid = wgid / nig, fm = gid * WGM, gsz = (nM - fm) < WGM ? (nM - fm) : WGM;
        u.pm = fm + ((wgid % nig) % gsz); u.pn = (wgid % nig) / gsz; return true;
    }
    __device__ __forceinline__ void a_ready(const Unit&) const {}
    __device__ __forceinline__ void done(const Unit&) const {}
};
__device__ __forceinline__ unsigned cvt_pk_bf16(float lo, float hi) { unsigned r; asm volatile("v_cvt_pk_bf16_f32 %0, %1, %2" : "=v"(r) : "v"(lo), "v"(hi)); return r; }
typedef unsigned u32x2 __attribute__((ext_vector_type(2)));
struct EpiBf16 {
    static constexpr bool PERM = true, AFTER_DRAIN = false;
    bf16_t* O; int ldc;
    __device__ __forceinline__ void operator()(const f32x4 (&acc)[2][2][4][2], const Unit& u, int wr, int wc, int fr, int fq) const {
        const int row0 = u.pm * BM + wr * 64 + fr; const int col0 = u.pn * BM + wc * 32 + 8 * fq;
#pragma unroll
        for (int ai = 0; ai < 2; ++ai)
#pragma unroll
            for (int m = 0; m < 4; ++m) { bf16_t* rowp = O + (size_t)(row0 + ai * HALF + m * 16) * ldc + col0;
#pragma unroll
                for (int bj = 0; bj < 2; ++bj) { const f32x4 v0 = acc[ai][bj][m][0], v1 = acc[ai][bj][m][1];
                    u32x4 w; w.x = cvt_pk_bf16(v0[0], v0[1]); w.y = cvt_pk_bf16(v0[2], v0[3]); w.z = cvt_pk_bf16(v1[0], v1[1]); w.w = cvt_pk_bf16(v1[2], v1[3]);
                    *(u32x4*)(rowp + bj * HALF) = w; } }
    }
};
struct EpiResid {
    static constexpr bool PERM = true, AFTER_DRAIN = false;
    const float* basef; float* outf; int ldc; bf16_t* xb; unsigned long long* ssq;
    __device__ __forceinline__ void operator()(const f32x4 (&acc)[2][2][4][2], const Unit& u, int wr, int wc, int fr, int fq) const {
        const int row0 = u.pm * BM + wr * 64 + fr, col0 = u.pn * BM + wc * 32 + 8 * fq;
#pragma unroll
        for (int ai = 0; ai < 2; ++ai) {
            u32x4 bw[4][2];
#pragma unroll
            for (int m = 0; m < 4; ++m)
#pragma unroll
                for (int bj = 0; bj < 2; ++bj) bw[m][bj] = *(const u32x4*)(xb + (size_t)(row0 + ai * HALF + m * 16) * ldc + col0 + bj * HALF);
#pragma unroll
            for (int m = 0; m < 4; ++m) { const int row = row0 + ai * HALF + m * 16; bf16_t* rowp = xb + (size_t)row * ldc + col0;
                float s = 0.f;
#pragma unroll
                for (int bj = 0; bj < 2; ++bj) { const u32x4 w0 = bw[m][bj];
                    const f32x4 y0 = (f32x4){__uint_as_float(w0.x << 16), __uint_as_float(w0.x & 0xffff0000u), __uint_as_float(w0.y << 16), __uint_as_float(w0.y & 0xffff0000u)} + acc[ai][bj][m][0];
                    const f32x4 y1 = (f32x4){__uint_as_float(w0.z << 16), __uint_as_float(w0.z & 0xffff0000u), __uint_as_float(w0.w << 16), __uint_as_float(w0.w & 0xffff0000u)} + acc[ai][bj][m][1];
                    u32x4 w; w.x = cvt_pk_bf16(y0[0], y0[1]); w.y = cvt_pk_bf16(y0[2], y0[3]); w.z = cvt_pk_bf16(y1[0], y1[1]); w.w = cvt_pk_bf16(y1[2], y1[3]);
                    *(u32x4*)(rowp + bj * HALF) = w;
                    s += ((y0[0] * y0[0] + y0[1] * y0[1]) + (y0[2] * y0[2] + y0[3] * y0[3])) + ((y1[0] * y1[0] + y1[1] * y1[1]) + (y1[2] * y1[2] + y1[3] * y1[3])); }
                s += __shfl_xor(s, 16); s += __shfl_xor(s, 32);
                if (fq == 0) atomicAdd(ssq + row, (unsigned long long)(s * 1048576.0f + 0.5f)); }
            asm volatile("" ::: "memory");
        }
    }
};
struct EpiSwiGLU {
    static constexpr bool PERM = true, AFTER_DRAIN = false;
    bf16_t* O; int ldc; const unsigned long long* ssq; float invd, eps;
    __device__ __forceinline__ void operator()(const f32x4 (&acc)[2][2][4][2], const Unit& u, int wr, int wc, int fr, int fq) const {
        const int row0 = u.pm * BM + wr * 64 + fr; const int col0 = u.pn * HALF + wc * 32 + 8 * fq;
        float rsv[2][4];
#pragma unroll
        for (int ai = 0; ai < 2; ++ai)
#pragma unroll
            for (int m = 0; m < 4; ++m) rsv[ai][m] = (float)ssq[row0 + ai * HALF + m * 16] * (1.0f / 1048576.0f);
#pragma unroll
        for (int ai = 0; ai < 2; ++ai)
#pragma unroll
            for (int m = 0; m < 4; ++m) rsv[ai][m] = 1.0f / sqrtf(rsv[ai][m] * invd + eps);
#pragma unroll
        for (int ai = 0; ai < 2; ++ai)
#pragma unroll
            for (int m = 0; m < 4; ++m) { bf16_t* rowp = O + (size_t)(row0 + ai * HALF + m * 16) * ldc + col0;
                const float rs = rsv[ai][m];
                float r[8];
#pragma unroll
                for (int n = 0; n < 2; ++n)
#pragma unroll
                    for (int j = 0; j < 4; ++j) { const float gt = acc[ai][0][m][n][j] * rs, up = acc[ai][1][m][n][j] * rs;
                        r[n * 4 + j] = gt * __builtin_amdgcn_rcpf(1.0f + __expf(-gt)) * up; }
                u32x4 w; w.x = cvt_pk_bf16(r[0], r[1]); w.y = cvt_pk_bf16(r[2], r[3]); w.z = cvt_pk_bf16(r[4], r[5]); w.w = cvt_pk_bf16(r[6], r[7]);
                *(u32x4*)rowp = w; }
    }
};

struct EpiProj {
    static constexpr bool PERM = true, AFTER_DRAIN = false;
    bf16_t* O; int ldc; const float* cs1; const float* cs2;
    const unsigned long long* ssq; float invd, eps;
    __device__ __forceinline__ void operator()(const f32x4 (&acc)[2][2][4][2], const Unit& u, int wr, int wc, int fr, int fq) const {
        const int row0 = u.pm * BM + wr * 64 + fr; const int col0 = u.pn * BM + wc * 32 + 8 * fq;
        const int kind = (u.pn >= 6 && u.pn < 9) ? 1 : (u.pn >= 15 && u.pn < 18) ? 2 : (u.pn >= 18 && u.pn < 22) ? 3 : 0;
        float rsv[2][4];
#pragma unroll
        for (int ai = 0; ai < 2; ++ai)
#pragma unroll
            for (int m = 0; m < 4; ++m) rsv[ai][m] = (float)ssq[row0 + ai * HALF + m * 16] * (1.0f / 1048576.0f);
#pragma unroll
        for (int ai = 0; ai < 2; ++ai)
#pragma unroll
            for (int m = 0; m < 4; ++m) rsv[ai][m] = 1.0f / sqrtf(rsv[ai][m] * invd + eps);
        f32x4 sc[2][2];
#pragma unroll
        for (int bj = 0; bj < 2; ++bj)
#pragma unroll
            for (int n = 0; n < 2; ++n) sc[bj][n] = (f32x4){1.f, 1.f, 1.f, 1.f};
        if (kind == 1 || kind == 2) { const float* cs = (kind == 1) ? cs1 + (col0 - 6 * BM) : cs2 + (col0 - 15 * BM);
#pragma unroll
            for (int bj = 0; bj < 2; ++bj)
#pragma unroll
                for (int n = 0; n < 2; ++n) sc[bj][n] = *(const f32x4*)(cs + bj * HALF + 4 * n); }
#pragma unroll
        for (int ai = 0; ai < 2; ++ai)
#pragma unroll
            for (int m = 0; m < 4; ++m) { bf16_t* rowp = O + (size_t)(row0 + ai * HALF + m * 16) * ldc + col0;
                const float rs = rsv[ai][m];
#pragma unroll
                for (int bj = 0; bj < 2; ++bj) { f32x4 v[2] = {acc[ai][bj][m][0] * rs, acc[ai][bj][m][1] * rs};
                    if (kind != 0) {
#pragma unroll
                        for (int n = 0; n < 2; ++n)
#pragma unroll
                            for (int j = 0; j < 4; ++j) { const float x = v[n][j];
                                const float z = (kind == 3) ? 1.5957691216057308f * (x + 0.044715f * x * x * x) : x;
                                const float sg = __builtin_amdgcn_rcpf(1.0f + __expf(-z));
                                v[n][j] = ((kind == 2) ? sg : x * sg) * sc[bj][n][j]; }
                    }
                    u32x4 w; w.x = cvt_pk_bf16(v[0][0], v[0][1]); w.y = cvt_pk_bf16(v[0][2], v[0][3]); w.z = cvt_pk_bf16(v[1][0], v[1][1]); w.w = cvt_pk_bf16(v[1][2], v[1][3]);
                    *(u32x4*)(rowp + bj * HALF) = w; } }
    }
};
template <class Epi, class Sched, bool ALIGN_EPI = false, bool SP2 = false>
__device__ __forceinline__ void gemm_phase(PG8_LAS unsigned char* lds, const Gemm g, const Sched& S, const Epi& E) {
    int tid_ = threadIdx.x; asm volatile("" : "+v"(tid_)); const int tid = tid_, wid = __builtin_amdgcn_readfirstlane(tid >> 6), lane = tid & 63, wr = wid >> 2, wc = wid & 3, fr = lane & 15, fq = lane >> 4;
    const int K = g.K, nt = K / BK;
    unsigned voffA[2], voffB[2];
#pragma unroll
    for (int i = 0; i < 2; ++i) { int R, C; stage_rc(tid * 16 + i * 8192, R, C); const int Rb = Epi::PERM ? ((R & ~31) + perm32(R & 31)) : R;
        voffA[i] = (unsigned)(R * K + C) * 2u; voffB[i] = (unsigned)(Rb * K + C) * 2u; }
    const size_t kstep = (size_t)(BK * 2);
    const size_t hstep = (size_t)HALF * K * 2;
    const size_t tstep = 2 * hstep;
    const unsigned ldsw = (unsigned)wid * 1024u;
    const int aoff = lds_byte(wr * 64 + fr, fq * 8), boff = lds_byte(wc * 32 + fr, fq * 8);
#define PG8_SA(b, h) (((b) * 2 + (h)) * HTB)
#define PG8_SB(b, h) ((4 + (b) * 2 + (h)) * HTB)
#define PG8_STAGE(bufoff, gbase, voff) do { _Pragma("unroll") for (int _i = 0; _i < 2; ++_i) \
        __builtin_amdgcn_global_load_lds((const unsigned*)((const char*)(gbase) + (voff)[_i]), (PG8_LAS unsigned*)(lds + (bufoff) + ldsw + _i * 8192), 16, 0, 0); } while (0)
#define PG8_LDA(dst, b, h) do { _Pragma("unroll") for (int m = 0; m < 4; ++m) _Pragma("unroll") for (int k = 0; k < 2; ++k) dst[m][k] = *(const PG8_LAS bf16x8*)(lds + PG8_SA(b, h) + aoff + m * 2048 + k * 1024); } while (0)
#define PG8_LDB(dst, b, h) do { _Pragma("unroll") for (int n = 0; n < 2; ++n) _Pragma("unroll") for (int k = 0; k < 2; ++k) dst[n][k] = *(const PG8_LAS bf16x8*)(lds + PG8_SB(b, h) + boff + n * 2048 + k * 1024); } while (0)
#define PG8_MMA(ai, bj, At, Bt) do { __builtin_amdgcn_s_setprio(1); _Pragma("unroll") for (int m = 0; m < 4; ++m) _Pragma("unroll") for (int n = 0; n < 2; ++n) _Pragma("unroll") for (int k = 0; k < 2; ++k) \
        acc[ai][bj][m][n] = __builtin_amdgcn_mfma_f32_16x16x32_bf16(Bt[n][k], At[m][k], acc[ai][bj][m][n], 0, 0, 0); __builtin_amdgcn_s_setprio(0); } while (0)
#define PG8_WAIT_V(n) asm volatile("s_waitcnt vmcnt(" #n ")" ::: "memory")
#define PG8_WAIT_L(n) asm volatile("s_waitcnt lgkmcnt(" #n ")" ::: "memory")
#define PG8_BAR __builtin_amdgcn_s_barrier()
#define PG8_SCHED __builtin_amdgcn_sched_barrier(0)
    Unit cur, nxt; int ui = 0;
    if (!S.next(0, cur)) return;
    f32x4 acc[2][2][4][2];
#pragma unroll
    for (int a = 0; a < 2; ++a)
#pragma unroll
        for (int b = 0; b < 2; ++b)
#pragma unroll
            for (int m = 0; m < 4; ++m)
#pragma unroll
                for (int n = 0; n < 2; ++n) acc[a][b][m][n] = (f32x4){0.f, 0.f, 0.f, 0.f};
    bf16x8 At[4][2], B0[2][2], B1[2][2];
    const char* cA = (const char*)g.A + (size_t)cur.pm * tstep; const char* cB = (const char*)g.Bt + (size_t)cur.pn * tstep;
    S.a_ready(cur);
    if constexpr (SP2) {
        PG8_STAGE(PG8_SB(0, 0), cB, voffB); PG8_STAGE(PG8_SB(0, 1), cB + hstep, voffB); PG8_STAGE(PG8_SA(0, 0), cA, voffA); PG8_STAGE(PG8_SA(0, 1), cA + hstep, voffA);
        if (wr == 1) PG8_BAR;
        PG8_WAIT_V(2); PG8_BAR;
        PG8_STAGE(PG8_SB(1, 0), cB + kstep, voffB); PG8_STAGE(PG8_SA(1, 0), cA + kstep, voffA); PG8_STAGE(PG8_SB(1, 1), cB + hstep + kstep, voffB);
        PG8_WAIT_V(6); PG8_BAR;
    } else {
        PG8_STAGE(PG8_SB(0, 0), cB, voffB); PG8_STAGE(PG8_SA(0, 0), cA, voffA); PG8_STAGE(PG8_SB(0, 1), cB + hstep, voffB); PG8_STAGE(PG8_SA(0, 1), cA + hstep, voffA);
        if (wr == 1) PG8_BAR;
        PG8_WAIT_V(4); PG8_BAR;
        PG8_STAGE(PG8_SB(1, 0), cB + kstep, voffB); PG8_STAGE(PG8_SA(1, 0), cA + kstep, voffA); PG8_STAGE(PG8_SB(1, 1), cB + hstep + kstep, voffB);
        PG8_WAIT_V(6); PG8_BAR;
    }
    for (;;) {
        const bool has_next = S.next(ui + 1, nxt);
        const char* nA = has_next ? (const char*)g.A + (size_t)nxt.pm * tstep : cA; const char* nB = has_next ? (const char*)g.Bt + (size_t)nxt.pn * tstep : cB;
        for (int t = 0; t < nt; t += 2) {
            const bool last = (t == nt - 2);
            const char* a1 = cA + (size_t)(t + 1) * kstep;
            const char* a2 = last ? nA : cA + (size_t)(t + 2) * kstep; const char* b2 = last ? nB : cB + (size_t)(t + 2) * kstep;
            const char* a3 = a2 + kstep; const char* b3 = b2 + kstep;
            if (last && has_next) S.a_ready(nxt);
            if constexpr (SP2) {
            PG8_LDB(B0, 0, 0); PG8_LDB(B1, 0, 1); PG8_SCHED; PG8_LDA(At, 0, 0); PG8_STAGE(PG8_SA(1, 1), a1 + hstep, voffA);
            PG8_WAIT_V(8); PG8_WAIT_L(0); PG8_BAR; PG8_MMA(0, 0, At, B0); PG8_MMA(0, 1, At, B1); PG8_BAR; PG8_SCHED;
            PG8_LDA(At, 0, 1); PG8_STAGE(PG8_SB(0, 0), b2, voffB); PG8_STAGE(PG8_SB(0, 1), b2 + hstep, voffB); PG8_STAGE(PG8_SA(0, 0), a2, voffA);
            PG8_WAIT_V(8); PG8_WAIT_L(0); PG8_BAR; PG8_MMA(1, 0, At, B0); PG8_MMA(1, 1, At, B1); PG8_BAR; PG8_SCHED;
            PG8_LDB(B0, 1, 0); PG8_LDB(B1, 1, 1); PG8_SCHED; PG8_LDA(At, 1, 0); PG8_STAGE(PG8_SA(0, 1), a2 + hstep, voffA);
            PG8_WAIT_V(8); PG8_WAIT_L(0); PG8_BAR; PG8_MMA(0, 0, At, B0); PG8_MMA(0, 1, At, B1); PG8_BAR; PG8_SCHED;
            PG8_LDA(At, 1, 1); PG8_STAGE(PG8_SB(1, 0), b3, voffB); PG8_STAGE(PG8_SB(1, 1), b3 + hstep, voffB); PG8_STAGE(PG8_SA(1, 0), a3, voffA);
            PG8_WAIT_V(8); PG8_WAIT_L(0); PG8_BAR; PG8_MMA(1, 0, At, B0); PG8_MMA(1, 1, At, B1); PG8_BAR; PG8_SCHED;
            } else {
            PG8_LDB(B0, 0, 0); PG8_SCHED; PG8_LDA(At, 0, 0); PG8_STAGE(PG8_SA(1, 1), a1 + hstep, voffA);
            PG8_WAIT_L(8); PG8_BAR; PG8_WAIT_L(0); PG8_MMA(0, 0, At, B0); PG8_BAR; PG8_SCHED;
            PG8_LDB(B1, 0, 1); PG8_STAGE(PG8_SB(0, 0), b2, voffB);
            PG8_BAR; PG8_WAIT_L(0); PG8_MMA(0, 1, At, B1); PG8_BAR;
            PG8_LDA(At, 0, 1); PG8_STAGE(PG8_SA(0, 0), a2, voffA);
            PG8_BAR; PG8_WAIT_L(0); PG8_MMA(1, 0, At, B0); PG8_BAR; PG8_SCHED;
            PG8_STAGE(PG8_SB(0, 1), b2 + hstep, voffB);
            PG8_WAIT_V(6); PG8_BAR; PG8_MMA(1, 1, At, B1); PG8_BAR;
            PG8_LDB(B0, 1, 0); PG8_SCHED; PG8_LDA(At, 1, 0); PG8_STAGE(PG8_SA(0, 1), a2 + hstep, voffA);
            PG8_WAIT_L(8); PG8_BAR; PG8_WAIT_L(0); PG8_MMA(0, 0, At, B0); PG8_BAR; PG8_SCHED;
            PG8_LDB(B1, 1, 1); PG8_STAGE(PG8_SB(1, 0), b3, voffB);
            PG8_BAR; PG8_WAIT_L(0); PG8_MMA(0, 1, At, B1); PG8_BAR;
            PG8_LDA(At, 1, 1); PG8_STAGE(PG8_SA(1, 0), a3, voffA);
            PG8_BAR; PG8_WAIT_L(0); PG8_MMA(1, 0, At, B0); PG8_BAR; PG8_SCHED;
            PG8_STAGE(PG8_SB(1, 1), b3 + hstep, voffB);
            PG8_WAIT_V(6); PG8_BAR; PG8_MMA(1, 1, At, B1); PG8_BAR;
            }
        }
        if constexpr (ALIGN_EPI) { if (wr == 0) PG8_BAR; }
        if constexpr (!Epi::AFTER_DRAIN) { E(acc, cur, wr, wc, fr, fq); S.done(cur); }
        if (!has_next) break;
#pragma unroll
        for (int a = 0; a < 2; ++a)
#pragma unroll
            for (int b = 0; b < 2; ++b)
#pragma unroll
                for (int m = 0; m < 4; ++m)
#pragma unroll
                    for (int n = 0; n < 2; ++n) acc[a][b][m][n] = (f32x4){0.f, 0.f, 0.f, 0.f};
        cur = nxt; cA = nA; cB = nB; ++ui;
        if constexpr (ALIGN_EPI) { if (wr == 1) PG8_BAR; }
    }
    PG8_WAIT_V(0);
    if constexpr (!ALIGN_EPI) { if (wr == 0) PG8_BAR; }
    PG8_BAR;
    if constexpr (Epi::AFTER_DRAIN) { E.fused(acc, cur, wr, wc, fr, fq, lds, wid, lane); S.done(cur); }
#undef PG8_SA
#undef PG8_SB
#undef PG8_STAGE
#undef PG8_LDA
#undef PG8_LDB
#undef PG8_MMA
#undef PG8_WAIT_V
#undef PG8_WAIT_L
#undef PG8_BAR
#undef PG8_SCHED
}
}

#define LAS __attribute__((address_space(3)))
typedef unsigned short bf16;
typedef float f32x4 __attribute__((ext_vector_type(4)));
typedef short bf16x8 __attribute__((ext_vector_type(8)));
typedef short s16x4 __attribute__((ext_vector_type(4)));
typedef unsigned u32x4 __attribute__((ext_vector_type(4)));
typedef unsigned u32x2 __attribute__((ext_vector_type(2)));

constexpr int NWAVES = 8, NT = 512;
constexpr int SEQ = 2048, M = 16384, D = 2048, NL = 2;
constexpr int P = 5656, PP = 5888, FF = 5632, NGU = 11264;
constexpr int GQ = 0, GK = 384, GV = 768, GG = 1536, MQ = 2304, MK = 2688, MV = 3072, MO = 3840, SU = 4608, SV = 5120, GA1 = 5632, MI = 5648, MF = 5652;
constexpr float EPS = 1e-6f;
constexpr float QK_SCALE = 0.10206207261596577f;
constexpr size_t MiB = 1u << 20;
constexpr size_t WS_LAYER = 97 * MiB, WS_WIN = 0, WS_WOUT = 23 * MiB, WS_WGU = 31 * MiB, WS_WDN = 75 * MiB;
constexpr size_t WS_XN = 194 * MiB, WS_PROJ = 258 * MiB, WS_MIX = 442 * MiB, WS_QG = 506 * MiB, WS_KG = 518 * MiB, WS_QM = 530 * MiB, WS_KM = 542 * MiB;
constexpr size_t WS_ELAST = 554 * MiB, WS_CUMF = 555 * MiB, WS_PMX = 556 * MiB, WS_CTL = 557 * MiB, WS_SSQ = 558 * MiB, WS_END = 559 * MiB;
constexpr size_t CTL_BYTES = 16384;

constexpr int LDS_BYTES = 147456;
constexpr int LDS_CTL_OFF = LDS_BYTES - 64;

struct Ctx {
    const float *x, *norm_mix, *w_in, *gla_a2, *gla_ab, *gla_norm, *ml_conv, *ml_ib, *ml_fb, *ml_norm, *sgu_ln_g, *sgu_ln_b, *sgu_w, *sgu_b, *w_out, *norm_ffn, *w_gu, *w_down, *norm_final;
    float* out; unsigned char* ws;
    bf16 *xn, *proj, *act, *mix, *qg, *kg, *qm, *km; float *elast, *cumf, *pmx;
};

__device__ __forceinline__ float bf2f(unsigned v) { return __uint_as_float(v << 16); }
__device__ __forceinline__ unsigned f2bf(float f) { unsigned u = __float_as_uint(f); return (u + 0x7fffu + ((u >> 16) & 1u)) >> 16; }
__device__ __forceinline__ unsigned pk2(float lo, float hi) { return pg8::cvt_pk_bf16(lo, hi); }
__device__ __forceinline__ float lo16(unsigned w) { return __uint_as_float(w << 16); }
__device__ __forceinline__ float hi16(unsigned w) { return __uint_as_float(w & 0xffff0000u); }
__device__ __forceinline__ float wave_sum(float v) {
#pragma unroll
    for (int o = 1; o < 64; o <<= 1) v += __shfl_xor(v, o);
    return v;
}
__device__ __forceinline__ float logsig(float z) { return fminf(z, 0.f) - log1pf(__expf(-fabsf(z))); }
__device__ __forceinline__ float logsig_fast(float z) { return fminf(z, 0.f) - __logf(1.0f + __expf(-fabsf(z))); }
__device__ __forceinline__ float sigmoidf_(float z) { return __builtin_amdgcn_rcpf(1.0f + __expf(-z)); }
__device__ __forceinline__ float gelu_tanh(float x) { const float u = 0.7978845608028654f * (x + 0.044715f * x * x * x); return x * sigmoidf_(2.0f * u); }
__device__ __forceinline__ s16x4 vtr(const LAS unsigned char* p) { typedef short v4i16_t __attribute__((ext_vector_type(4))); return __builtin_bit_cast(s16x4, __builtin_amdgcn_ds_read_tr16_b64_v4i16((LAS v4i16_t*)p)); }
__device__ __forceinline__ bf16x8 vtr2(const LAS unsigned char* p, int step) { const s16x4 lo = vtr(p), hi = vtr(p + step); return __builtin_shufflevector(lo, hi, 0, 1, 2, 3, 4, 5, 6, 7); }
__device__ __forceinline__ bf16x8 ld128(const LAS unsigned char* p) { return *(const LAS bf16x8*)p; }
#define WG_BAR() do { asm volatile("s_waitcnt lgkmcnt(0)" ::: "memory"); __builtin_amdgcn_s_barrier(); asm volatile("" ::: "memory"); } while (0)
#define MFMA16(a, b, c) __builtin_amdgcn_mfma_f32_16x16x32_bf16((a), (b), (c), 0, 0, 0)

constexpr int I_IN = 32 * (PP / 32), I_OUT = 32 * (D / 32), I_GU = 32 * (NGU / 32), I_DN = (FF / 64) * (D / 32), I_L = I_IN + I_OUT + I_GU + I_DN;
template <bool REMAP> __device__ __forceinline__ void transpose_item(const float* W, int K, int N, bf16* WT, int dst_row0, int k0, int n0, LAS float* scr, int lane, const float* gk) {
    int n = n0 + (lane & 31); bool ok = n < N;
    if (REMAP) { const int d = n;
        n = d < 2304 ? d : d < 4608 ? d + 16 : d < 5632 ? d + 24 : d < 5648 ? d - 5632 + 2304 : d < 5656 ? d - 5648 + 4624 : 0; ok = d < 5656; }
    float wv_[32];
#pragma unroll
    for (int i = 0; i < 32; ++i) { const int kk = 2 * i + (lane >> 5); wv_[i] = ok ? W[(size_t)(k0 + kk) * N + n] : 0.f; }
#pragma unroll
    for (int i = 0; i < 32; ++i) { const int kk = 2 * i + (lane >> 5); scr[kk * 33 + (lane & 31)] = wv_[i]; }
    asm volatile("s_waitcnt lgkmcnt(0)" ::: "memory");
    const int c = lane & 7;
    f32x4 g0 = (f32x4){1.f, 1.f, 1.f, 1.f}, g1 = g0;
    if (gk) { g0 = *(const f32x4*)(gk + k0 + 8 * c); g1 = *(const f32x4*)(gk + k0 + 8 * c + 4); }
#pragma unroll
    for (int j = 0; j < 4; ++j) { const int nn = (lane >> 3) + 8 * j; const LAS float* s = scr + (8 * c) * 33 + nn;
        u32x4 o; o.x = pk2(s[0 * 33] * g0.x, s[1 * 33] * g0.y); o.y = pk2(s[2 * 33] * g0.z, s[3 * 33] * g0.w); o.z = pk2(s[4 * 33] * g1.x, s[5 * 33] * g1.y); o.w = pk2(s[6 * 33] * g1.z, s[7 * 33] * g1.w);
        *(u32x4*)(WT + (size_t)(dst_row0 + nn) * K + k0 + 8 * c) = o; }
    asm volatile("s_waitcnt lgkmcnt(0)" ::: "memory");
}
__device__ __forceinline__ void convert_weights(const Ctx& X, LAS unsigned char* lds, int gwb, int ngw, int it_lo, int it_hi) {
    int tid_ = threadIdx.x; asm volatile("" : "+v"(tid_)); const int lane = tid_ & 63, wave = __builtin_amdgcn_readfirstlane(tid_ >> 6), gw = gwb + wave;
    LAS float* scr = (LAS float*)(lds + wave * 16384);
    for (int it = it_lo + gw; it < it_hi; it += ngw) {
        const int l = it / I_L; int r = it - l * I_L; unsigned char* wl = X.ws + (size_t)l * WS_LAYER;
        if (r < I_IN) { const int nb = PP / 32, kb = r / nb, n0 = 32 * (r % nb); transpose_item<true>(X.w_in + (size_t)l * D * P, D, P, (bf16*)(wl + WS_WIN), n0, 64 * kb, n0, scr, lane, X.norm_mix + l * D); continue; } r -= I_IN;
        if (r < I_OUT) { const int nb = D / 32, kb = r / nb, n0 = 32 * (r % nb); transpose_item<false>(X.w_out + (size_t)l * D * D, D, D, (bf16*)(wl + WS_WOUT), n0, 64 * kb, n0, scr, lane, nullptr); continue; } r -= I_OUT;
        if (r < I_GU) { const int nb = NGU / 32, kb = r / nb, n0 = 32 * (r % nb); const int up = n0 >= FF, nn = n0 - up * FF, dr = 256 * (nn / 128) + 128 * up + (nn % 128);
            transpose_item<false>(X.w_gu + (size_t)l * D * NGU, D, NGU, (bf16*)(wl + WS_WGU), dr, 64 * kb, n0, scr, lane, X.norm_ffn + l * D); continue; } r -= I_GU;
        { const int nb = D / 32, kb = r / nb, n0 = 32 * (r % nb); transpose_item<false>(X.w_down + (size_t)l * FF * D, FF, D, (bf16*)(wl + WS_WDN), n0, 64 * kb, n0, scr, lane, nullptr); }
    }
}
__device__ __forceinline__ void rows_bf16_ssq(const float* x, bf16* ob, unsigned long long* ssq, int gwb, int ngw) {
    int tid_ = threadIdx.x; asm volatile("" : "+v"(tid_)); const int lane = tid_ & 63, gw = gwb + __builtin_amdgcn_readfirstlane(tid_ >> 6);
    for (int m = gw; m < M; m += ngw) {
        const f32x4* xr = (const f32x4*)(x + (size_t)m * D) + lane; f32x4 v[8]; float s = 0.f;
#pragma unroll
        for (int j = 0; j < 8; ++j) { v[j] = xr[64 * j]; s += (v[j].x * v[j].x + v[j].y * v[j].y) + (v[j].z * v[j].z + v[j].w * v[j].w); }
        s = wave_sum(s);
#pragma unroll
        for (int j = 0; j < 8; ++j) { u32x2 w; w.x = pk2(v[j].x, v[j].y); w.y = pk2(v[j].z, v[j].w); *((u32x2*)(ob + (size_t)m * D) + lane + 64 * j) = w; }
        if (lane == 0) ssq[m] = (unsigned long long)(s * 1048576.0f + 0.5f);
    }
}
__device__ __forceinline__ void rows_final_norm(const bf16* xb, float* out, const float* g, const unsigned long long* ssq, int gwb, int ngw, int nrows) {
    int tid_ = threadIdx.x; asm volatile("" : "+v"(tid_)); const int lane = tid_ & 63, gw = gwb + __builtin_amdgcn_readfirstlane(tid_ >> 6);
    f32x4 gv[8];
#pragma unroll
    for (int j = 0; j < 8; ++j) gv[j] = *((const f32x4*)g + lane + 64 * j);
    for (int m = gw; m < nrows; m += ngw) {
        const u32x2* xr = (const u32x2*)(xb + (size_t)m * D) + lane; f32x4* orow = (f32x4*)(out + (size_t)m * D) + lane; const float rstd = 1.0f / sqrtf((float)ssq[m] * (1.0f / 1048576.0f) * (1.0f / D) + EPS);
        u32x2 w[8];
#pragma unroll
        for (int j = 0; j < 8; ++j) w[j] = xr[64 * j];
#pragma unroll
        for (int j = 0; j < 8; ++j) { const f32x4 v = (f32x4){lo16(w[j].x), hi16(w[j].x), lo16(w[j].y), hi16(w[j].y)}; __builtin_nontemporal_store(v * rstd * gv[j], orow + 64 * j); }
    }
}

__device__ __forceinline__ void prepass_item(const Ctx& X, int l, int item, LAS unsigned char* lds) {
    int tid_ = threadIdx.x; asm volatile("" : "+v"(tid_)); const int tid = tid_, lane = tid & 63, wid = tid >> 6;
    const int b = item >> 5, c = item & 31; const size_t row0 = (size_t)b * SEQ + c * 64;
    LAS float* ga = (LAS float*)lds;
    LAS float* ea = (LAS float*)(lds + 4096);
    constexpr int TOFF = 8192, RP = 1552;
    const bf16* proj = X.proj;
    u32x4 ta[12], tb[13];
#pragma unroll
    for (int j = 0; j < 12; ++j) { const int p = tid + 512 * j, row = p / 96, pc = p % 96; ta[j] = *(const u32x4*)(proj + (row0 + row) * PP + GQ + pc * 8); }
#pragma unroll
    for (int j = 0; j < 13; ++j) { const int p = tid + 512 * j, row = p / 96, pc = p % 96; tb[j] = (u32x4){0u, 0u, 0u, 0u};
        if (p < 67 * 96 && (c > 0 || row >= 3)) tb[j] = *(const u32x4*)(proj + (row0 + row - 3) * PP + MQ + pc * 8); }
    if (wid < 4) {
        const int h = wid; const size_t r = row0 + lane;
        const float ip = bf2f(proj[r * PP + MI + h]) + X.ml_ib[l * 4 + h];
        const float lf = logsig(bf2f(proj[r * PP + MF + h]) + X.ml_fb[l * 4 + h]);
        float cum = lf;
#pragma unroll
        for (int o = 1; o < 64; o <<= 1) { const float v = __shfl_up(cum, o); if (lane >= o) cum += v; }
        const float a = ip - cum; float pm = a;
#pragma unroll
        for (int o = 1; o < 64; o <<= 1) { const float v = __shfl_up(pm, o); if (lane >= o) pm = fmaxf(pm, v); }
        X.cumf[r * 4 + h] = cum; X.pmx[r * 4 + h] = pm; ea[lane * 4 + h] = __expf(a);
    } else {
        const int i = tid - 256;
#pragma unroll
        for (int k = 0; k < 4; ++k) { const int e = i + 256 * k, t = e >> 4, rr = e & 15; ga[e] = bf2f(proj[(row0 + t) * PP + GA1 + rr]); }
    }
#pragma unroll
    for (int j = 0; j < 12; ++j) { const int p = tid + 512 * j, row = p / 96, pc = p % 96; *(LAS u32x4*)(lds + TOFF + row * RP + pc * 16) = ta[j]; }
    __syncthreads();
    if (tid < 384) {
        const int col = tid; float a2r[16];
#pragma unroll
        for (int r = 0; r < 16; ++r) a2r[r] = X.gla_a2[(size_t)(l * 16 + r) * 384 + col];
        const float ab = X.gla_ab[l * 384 + col]; float cum = 0.f;
        LAS unsigned short* qc = (LAS unsigned short*)(lds + TOFF + col * 2); LAS unsigned short* kc = (LAS unsigned short*)(lds + TOFF + (384 + col) * 2);
#pragma unroll 4
        for (int t = 0; t < 64; ++t) {
            float z = ab;
#pragma unroll
            for (int r = 0; r < 16; ++r) z += ga[t * 16 + r] * a2r[r];
            cum += logsig_fast(z) * (1.0f / 16.0f);
            const float e = __expf(cum), ei = __expf(-cum);
            const float q = bf2f(qc[t * (RP / 2)]), kk = bf2f(kc[t * (RP / 2)]);
            qc[t * (RP / 2)] = (unsigned short)f2bf(q * e * QK_SCALE); kc[t * (RP / 2)] = (unsigned short)f2bf(kk * ei);
        }
        X.elast[(size_t)(b * 32 + c) * 384 + col] = __expf(cum);
    }
    __syncthreads();
#pragma unroll
    for (int j = 0; j < 12; ++j) { const int p = tid + 512 * j, row = p / 96, pc = p % 96; const u32x4 v = *(const LAS u32x4*)(lds + TOFF + row * RP + pc * 16);
        bf16* dstp = (pc >= 48 ? X.kg : X.qg) + (row0 + row) * 384 + (pc % 48) * 8; *(u32x4*)dstp = v; }
    __syncthreads();
#pragma unroll
    for (int j = 0; j < 13; ++j) { const int p = tid + 512 * j, row = p / 96, pc = p % 96; if (p < 67 * 96) *(LAS u32x4*)(lds + TOFF + row * RP + pc * 16) = tb[j]; }
    __syncthreads();
    for (int cc = tid; cc < 768; cc += NT) {
        const float w0 = X.ml_conv[(size_t)(l * 4 + 0) * 768 + cc], w1 = X.ml_conv[(size_t)(l * 4 + 1) * 768 + cc], w2 = X.ml_conv[(size_t)(l * 4 + 2) * 768 + cc], w3 = X.ml_conv[(size_t)(l * 4 + 3) * 768 + cc];
        LAS unsigned short* xc_ = (LAS unsigned short*)(lds + TOFF + cc * 2);
        float x3 = bf2f(xc_[0]), x2 = bf2f(xc_[RP / 2]), x1 = bf2f(xc_[2 * (RP / 2)]);
        const bool isk = cc >= 384; const int hh = isk ? (cc - 384) / 96 : 0;
#pragma unroll 4
        for (int t = 0; t < 64; ++t) {
            const float xc = bf2f(xc_[(t + 3) * (RP / 2)]);
            const float y = w0 * x3 + w1 * x2 + w2 * x1 + w3 * xc; float s = y * sigmoidf_(y);
            if (isk) s *= QK_SCALE * ea[t * 4 + hh];
            xc_[(t + 3) * (RP / 2)] = (unsigned short)f2bf(s); x3 = x2; x2 = x1; x1 = xc;
        }
    }
    __syncthreads();
#pragma unroll
    for (int j = 0; j < 12; ++j) { const int p = tid + 512 * j, row = p / 96, pc = p % 96; const u32x4 v = *(const LAS u32x4*)(lds + TOFF + (row + 3) * RP + pc * 16);
        bf16* dstp = (pc >= 48 ? X.km : X.qm) + (row0 + row) * 384 + (pc % 48) * 8; *(u32x4*)dstp = v; }
    __syncthreads();
}

constexpr int SC_QS = 0, SC_KS = 13312, SC_VS = 26624, SC_PS = 54272, SC_ST = 63488, SC_RED = 106752, SC_DEN = 107776, SC_GT = 108032, SC_GN = 108544;
constexpr int QP = 208, VP = 432, PPI = 144, STP = 208;
template <bool ML> __device__ __forceinline__ void scan_item(const Ctx& X, int l, int b, int h, LAS unsigned char* lds) {
    int tid_ = threadIdx.x; asm volatile("" : "+v"(tid_)); const int tid = tid_, lane = tid & 63, wid = __builtin_amdgcn_readfirstlane(tid >> 6);
    const int wh = wid >> 2, wq = wid & 3;
#define LANEV int ln_ = lane; asm volatile("" : "+v"(ln_)); const int r = ln_ & 15, g = ln_ >> 4, q4 = (ln_ & 15) >> 2, p4 = ln_ & 3; (void)r; (void)g; (void)q4; (void)p4;
    const bool v4 = ML && (wq == 3);
    const bf16* qsrc = (ML ? X.qm : X.qg) + h * 96; const bf16* ksrc = (ML ? X.km : X.kg) + h * 96;
    const bf16* vsrc = X.proj + (ML ? MV : GV) + h * 192; const bf16* gsrc = X.proj + (ML ? MO : GG) + h * 192;
    bf16* dst = X.mix + (ML ? 768 : 0) + h * 192;
    const size_t rowb = (size_t)b * SEQ;
    unsigned z_ = 0u, one_ = ML ? 0x00003F80u : 0u; asm volatile("" : "+v"(z_), "+v"(one_));
    for (int i = tid; i < (208 * STP) / 16; i += NT) *(LAS u32x4*)(lds + SC_ST + i * 16) = (u32x4){z_, z_, z_, z_};
    if (tid < 64) { LAS unsigned* vp = (LAS unsigned*)(lds + SC_VS + tid * VP + 384);
#pragma unroll
        for (int i = 0; i < 8; ++i) vp[i] = (i == 0) ? one_ : z_; }
#define STG_OFFS int t_ = tid; asm volatile("" : "+v"(t_)); const int qr_ = t_ >> 4, qc_ = t_ & 15, vr_ = t_ >> 5, vc_ = t_ & 31; const bool qok_ = qc_ < 12, vok_ = vc_ < 24; \
        const unsigned qoff = (unsigned)(qr_ * 384 + qc_ * 8), qlds = (unsigned)(qr_ * QP + qc_ * 16), voff = (unsigned)(vr_ * PP + vc_ * 8), vlds = (unsigned)(vr_ * VP + vc_ * 16); \
        (void)qoff; (void)qlds; (void)voff; (void)vlds; (void)qok_; (void)vok_;
    u32x4 sq[2], sk[2], sv[4]; f32x4 sg = (f32x4){0.f, 0.f, 0.f, 0.f};
#pragma unroll
    for (int p = 0; p < 2; ++p) { sq[p] = (u32x4){0u, 0u, 0u, 0u}; sk[p] = sq[p]; }
#pragma unroll
    for (int p = 0; p < 4; ++p) sv[p] = (u32x4){0u, 0u, 0u, 0u};
#define SC_LOAD(c_) do { STG_OFFS const size_t rb_ = rowb + (size_t)(c_) * 64; const bf16* qb_ = qsrc + rb_ * 384; const bf16* kb_ = ksrc + rb_ * 384; const bf16* vb_ = vsrc + rb_ * PP; \
        if (qok_) { _Pragma("unroll") for (int p = 0; p < 2; ++p) { sq[p] = *(const u32x4*)(qb_ + qoff + p * (32 * 384)); sk[p] = *(const u32x4*)(kb_ + qoff + p * (32 * 384)); } } \
        if (vok_) { _Pragma("unroll") for (int p = 0; p < 4; ++p) sv[p] = *(const u32x4*)(vb_ + voff + p * (16 * PP)); } \
        if (ML) { if (tid < 64) { sg.x = X.pmx[(rb_ + tid) * 4 + h]; sg.y = X.cumf[(rb_ + tid) * 4 + h]; } } \
        else { if (tid < 24) sg = *(const f32x4*)(X.elast + (size_t)(b * 32 + (c_)) * 384 + h * 96 + 4 * tid); } } while (0)
#define SC_STORE() do { STG_OFFS \
        if (qok_) { _Pragma("unroll") for (int p = 0; p < 2; ++p) { *(LAS u32x4*)(lds + SC_QS + qlds + p * (32 * QP)) = sq[p]; *(LAS u32x4*)(lds + SC_KS + qlds + p * (32 * QP)) = sk[p]; } } \
        if (vok_) { _Pragma("unroll") for (int p = 0; p < 4; ++p) *(LAS u32x4*)(lds + SC_VS + vlds + p * (16 * VP)) = sv[p]; } \
        if (ML) { if (tid < 64) { *(LAS float*)(lds + SC_GT + tid * 4) = sg.x; *(LAS float*)(lds + SC_GT + 256 + tid * 4) = sg.y; } } \
        else { if (tid < 24) *(LAS f32x4*)(lds + SC_GT + tid * 16) = sg; } } while (0)
#define GT_PM(t_) (*(const LAS float*)(lds + SC_GT + (t_) * 4))
#define GT_CUM(t_) (*(const LAS float*)(lds + SC_GT + 256 + (t_) * 4))
    SC_LOAD(0); SC_STORE();
    f32x4 sacc[3][4];
#pragma unroll
    for (int i = 0; i < 3; ++i)
#pragma unroll
        for (int j = 0; j < 4; ++j) sacc[i][j] = (f32x4){0.f, 0.f, 0.f, 0.f};
    float m_st = 0.f;
    const int tb1 = wid >> 1;
    __syncthreads();
    for (int c = 0; c < 32; ++c) {
        const size_t rbc = rowb + (size_t)c * 64;
        if (c + 1 < 32) { SC_LOAD(c + 1); }
        float pm63 = 0.f, cum63 = 0.f, pmt[2] = {0.f, 0.f}, cumt[2] = {0.f, 0.f};
        if (ML) { LANEV pm63 = GT_PM(63); cum63 = GT_CUM(63);
#pragma unroll
            for (int ti = 0; ti < 2; ++ti) { pmt[ti] = GT_PM(16 * (2 * wh + ti) + r); cumt[ti] = GT_CUM(16 * (2 * wh + ti) + r); } }
        u32x2 gate[2][3];
        { LANEV const bf16* gb_ = gsrc + rbc * PP;
#pragma unroll
        for (int ti = 0; ti < 2; ++ti)
#pragma unroll
            for (int vi = 0; vi < 3; ++vi) gate[ti][vi] = *(const u32x2*)(gb_ + (unsigned)((16 * (2 * wh + ti) + r) * PP + 16 * (3 * wq + vi) + 4 * g)); }
        {
            LANEV bf16x8 qf[3], kf[2][3];
#pragma unroll
            for (int ds = 0; ds < 3; ++ds) qf[ds] = ld128(lds + SC_QS + (16 * tb1 + r) * QP + (32 * ds + 8 * g) * 2);
#pragma unroll
            for (int si = 0; si < 2; ++si)
#pragma unroll
                for (int ds = 0; ds < 3; ++ds) kf[si][ds] = ld128(lds + SC_KS + (16 * (2 * (wid & 1) + si) + r) * QP + (32 * ds + 8 * g) * 2);
            __builtin_amdgcn_sched_barrier(0);
#pragma unroll
            for (int si = 0; si < 2; ++si) {
                const int sb = 2 * (wid & 1) + si; f32x4 acc = (f32x4){0.f, 0.f, 0.f, 0.f};
                if (sb <= tb1) {
#pragma unroll
                    for (int ds = 0; ds < 3; ++ds) acc = MFMA16(kf[si][ds], qf[ds], acc);
#pragma unroll
                    for (int j = 0; j < 4; ++j) { const bool keep = (16 * sb + 4 * g + j) <= (16 * tb1 + r); acc[j] = keep ? acc[j] : 0.f; }
                }
                u32x2 w; w.x = pk2(acc[0], acc[1]); w.y = pk2(acc[2], acc[3]);
                *(LAS u32x2*)(lds + SC_PS + (16 * tb1 + r) * PPI + (16 * sb + 4 * g) * 2) = w;
            }
        }
        f32x4 oacc[2][4];
#pragma unroll
        for (int ti = 0; ti < 2; ++ti)
#pragma unroll
            for (int vi = 0; vi < 4; ++vi) oacc[ti][vi] = (f32x4){0.f, 0.f, 0.f, 0.f};
        {
            LANEV bf16x8 qf[2][3];
#pragma unroll
            for (int ti = 0; ti < 2; ++ti)
#pragma unroll
                for (int ds = 0; ds < 3; ++ds) qf[ti][ds] = ld128(lds + SC_QS + (16 * (2 * wh + ti) + r) * QP + (32 * ds + 8 * g) * 2);
#pragma unroll
            for (int vh = 0; vh < 2; ++vh) {
                bf16x8 sf[2][3];
#pragma unroll
                for (int v2 = 0; v2 < 2; ++v2)
#pragma unroll
                    for (int ds = 0; ds < 3; ++ds) { const int vi = 2 * vh + v2;
                        if (vi < 3 || v4) sf[v2][ds] = ld128(lds + SC_ST + (16 * (3 * wq + vi) + r) * STP + (32 * ds + 8 * g) * 2); else sf[v2][ds] = (bf16x8){0, 0, 0, 0, 0, 0, 0, 0}; }
                __builtin_amdgcn_sched_barrier(0);
#pragma unroll
                for (int v2 = 0; v2 < 2; ++v2) { const int vi = 2 * vh + v2;
                    if (vi < 3 || v4) {
#pragma unroll
                        for (int ds = 0; ds < 3; ++ds)
#pragma unroll
                            for (int ti = 0; ti < 2; ++ti) oacc[ti][vi] = MFMA16(sf[v2][ds], qf[ti][ds], oacc[ti][vi]);
                    } }
                __builtin_amdgcn_sched_barrier(0);
            }
        }
        WG_BAR();
        bf16x8 vf[4][2];
        { LANEV
#pragma unroll
        for (int vi = 0; vi < 4; ++vi)
#pragma unroll
            for (int ss = 0; ss < 2; ++ss)
                if (vi < 3 || v4) vf[vi][ss] = vtr2(lds + SC_VS + (32 * ss + 8 * g + q4) * VP + (16 * (3 * wq + vi) + 4 * p4) * 2, 4 * VP);
                else vf[vi][ss] = (bf16x8){0, 0, 0, 0, 0, 0, 0, 0};
        }
        {
            LANEV bf16x8 pf[2][2];
#pragma unroll
            for (int ti = 0; ti < 2; ++ti)
#pragma unroll
                for (int ss = 0; ss < 2; ++ss) pf[ti][ss] = ld128(lds + SC_PS + (16 * (2 * wh + ti) + r) * PPI + (32 * ss + 8 * g) * 2);
            __builtin_amdgcn_sched_barrier(0);
#pragma unroll
            for (int vi = 0; vi < 4; ++vi)
                if (vi < 3 || v4) {
#pragma unroll
                    for (int ti = 0; ti < 2; ++ti)
#pragma unroll
                        for (int ss = 0; ss < 2; ++ss) oacc[ti][vi] = MFMA16(vf[vi][ss], pf[ti][ss], oacc[ti][vi]);
                }
        }
        { LANEV
#pragma unroll
        for (int ti = 0; ti < 2; ++ti) {
            float s = 0.f;
#pragma unroll
            for (int vi = 0; vi < 3; ++vi)
#pragma unroll
                for (int j = 0; j < 4; ++j) s += oacc[ti][vi][j] * oacc[ti][vi][j];
            s += __shfl_xor(s, 16); s += __shfl_xor(s, 32);
            if (g == 0) { *(LAS float*)(lds + SC_RED + ((16 * (2 * wh + ti) + r) * 4 + wq) * 4) = s; if (v4) *(LAS float*)(lds + SC_DEN + (16 * (2 * wh + ti) + r) * 4) = oacc[ti][3][0]; }
        } }
        u32x2 opk[2][3];
#pragma unroll
        for (int ti = 0; ti < 2; ++ti)
#pragma unroll
            for (int vi = 0; vi < 3; ++vi) { opk[ti][vi].x = pk2(oacc[ti][vi][0], oacc[ti][vi][1]); opk[ti][vi].y = pk2(oacc[ti][vi][2], oacc[ti][vi][3]); }
        {
            LANEV const float e_out = ML ? __expf(cum63) : 1.0f;
            bf16x8 kt[3][2];
#pragma unroll
            for (int di = 0; di < 3; ++di)
#pragma unroll
                for (int ss = 0; ss < 2; ++ss) kt[di][ss] = vtr2(lds + SC_KS + (32 * ss + 8 * g + q4) * QP + (16 * (3 * wh + di) + 4 * p4) * 2, 4 * QP);
            __builtin_amdgcn_sched_barrier(0);
#pragma unroll
            for (int di = 0; di < 3; ++di)
#pragma unroll
                for (int vi = 0; vi < 4; ++vi)
                    if (vi < 3 || v4) {
#pragma unroll
                        for (int ss = 0; ss < 2; ++ss) sacc[di][vi] = MFMA16(kt[di][ss], vf[vi][ss], sacc[di][vi]);
                    }
            __builtin_amdgcn_sched_barrier(0);
#pragma unroll
            for (int di = 0; di < 3; ++di) {
                f32x4 dec = (f32x4){e_out, e_out, e_out, e_out};
                if (!ML) dec = *(const LAS f32x4*)(lds + SC_GT + (16 * (3 * wh + di) + 4 * g) * 4);
#pragma unroll
                for (int vi = 0; vi < 4; ++vi)
                    if (vi < 3 || v4) {
                        const f32x4 a = sacc[di][vi] * dec; sacc[di][vi] = a;
                        u32x2 w; w.x = pk2(a[0], a[1]); w.y = pk2(a[2], a[3]);
                        *(LAS u32x2*)(lds + SC_ST + (16 * (3 * wq + vi) + r) * STP + (16 * (3 * wh + di) + 4 * g) * 2) = w;
                    }
            }
        }
        WG_BAR();
        { LANEV
#pragma unroll
        for (int ti = 0; ti < 2; ++ti) {
            const int t = 16 * (2 * wh + ti) + r;
            const f32x4 rp = *(const LAS f32x4*)(lds + SC_RED + t * 16);
            float ssq = (rp.x + rp.y) + (rp.z + rp.w), inv = 1.0f;
            if (ML) { const float Mt = fmaxf(m_st, pmt[ti]), eM = __expf(-Mt); const float den = *(const LAS float*)(lds + SC_DEN + t * 4) * eM;
                const float dn = fmaxf(fabsf(den), __expf(-(cumt[ti] + Mt))); inv = eM / dn; ssq = ssq * inv * inv; }
            const float rstd = inv / sqrtf(ssq * (1.0f / 192.0f) + EPS);
#pragma unroll
            for (int vi = 0; vi < 3; ++vi) {
                const int dv = 16 * (3 * wq + vi) + 4 * g;
                const float a0 = lo16(gate[ti][vi].x) * rstd, a1 = hi16(gate[ti][vi].x) * rstd, a2 = lo16(gate[ti][vi].y) * rstd, a3 = hi16(gate[ti][vi].y) * rstd;
                const f32x4 o = (f32x4){lo16(opk[ti][vi].x), hi16(opk[ti][vi].x), lo16(opk[ti][vi].y), hi16(opk[ti][vi].y)};
                u32x2 w; w.x = pk2(o[0] * a0, o[1] * a1); w.y = pk2(o[2] * a2, o[3] * a3);
                *(u32x2*)(dst + rbc * D + (unsigned)(t * D + dv)) = w;
            }
        } }
        if (ML) m_st = cum63 + fmaxf(m_st, pm63);
        if (c + 1 < 32) SC_STORE();
        WG_BAR();
    }
#undef SC_LOAD
#undef SC_STORE
#undef LANEV
#undef STG_OFFS
#undef GT_PM
#undef GT_CUM
}

constexpr int SG_W = 0, SG_V = 34816, SGP = 272;
__device__ __forceinline__ void sgu_item(const Ctx& X, int l, int item, LAS unsigned char* lds) {
    int tid_ = threadIdx.x; asm volatile("" : "+v"(tid_)); const int tid = tid_, lane = tid & 63, wid = __builtin_amdgcn_readfirstlane(tid >> 6);
    const int r = lane & 15, g = lane >> 4, q4 = (lane & 15) >> 2, p4 = lane & 3;
    const int grp = item & 3, nb = (item >> 2) & 15, b = item >> 6; const size_t row0 = (size_t)b * SEQ + nb * 128;
    u32x4 raw[16];
#pragma unroll
    for (int i = 0; i < 16; ++i) raw[i] = *(const u32x4*)(X.proj + (row0 + wid * 16 + i) * PP + SV + lane * 8);
    float lgv[8], lbv[8];
    { const f32x4 a0 = *(const f32x4*)(X.sgu_ln_g + l * 512 + lane * 8), a1 = *(const f32x4*)(X.sgu_ln_g + l * 512 + lane * 8 + 4), b0 = *(const f32x4*)(X.sgu_ln_b + l * 512 + lane * 8), b1 = *(const f32x4*)(X.sgu_ln_b + l * 512 + lane * 8 + 4);
      lgv[0] = a0.x; lgv[1] = a0.y; lgv[2] = a0.z; lgv[3] = a0.w; lgv[4] = a1.x; lgv[5] = a1.y; lgv[6] = a1.z; lgv[7] = a1.w;
      lbv[0] = b0.x; lbv[1] = b0.y; lbv[2] = b0.z; lbv[3] = b0.w; lbv[4] = b1.x; lbv[5] = b1.y; lbv[6] = b1.z; lbv[7] = b1.w; }
    { const float* wsrc = X.sgu_w + (size_t)(l * 4 + grp) * 16384; f32x4 wv[8];
#pragma unroll
        for (int k = 0; k < 8; ++k) { const int e = tid + 512 * k, t = e >> 5, s0 = (e & 31) * 4; wv[k] = *(const f32x4*)(wsrc + t * 128 + s0); }
#pragma unroll
        for (int k = 0; k < 8; ++k) { const int e = tid + 512 * k, t = e >> 5, s0 = (e & 31) * 4; const f32x4 w = wv[k];
            u32x2 o; o.x = pk2(s0 <= t ? w.x : 0.f, s0 + 1 <= t ? w.y : 0.f); o.y = pk2(s0 + 2 <= t ? w.z : 0.f, s0 + 3 <= t ? w.w : 0.f);
            *(LAS u32x2*)(lds + SG_W + t * SGP + s0 * 2) = o; } }
#pragma unroll
    for (int i = 0; i < 16; ++i) {
        const int s = wid * 16 + i; const u32x4 rw = raw[i];
        float v[8]; v[0] = lo16(rw.x); v[1] = hi16(rw.x); v[2] = lo16(rw.y); v[3] = hi16(rw.y); v[4] = lo16(rw.z); v[5] = hi16(rw.z); v[6] = lo16(rw.w); v[7] = hi16(rw.w);
        float sm = 0.f;
#pragma unroll
        for (int j = 0; j < 8; ++j) sm += v[j];
        const float mu = wave_sum(sm) * (1.0f / 512.0f); float sq = 0.f;
#pragma unroll
        for (int j = 0; j < 8; ++j) { v[j] -= mu; sq += v[j] * v[j]; }
        const float rstd = 1.0f / sqrtf(wave_sum(sq) * (1.0f / 512.0f) + EPS);
        if ((lane >> 4) == grp) { float y[8];
#pragma unroll
            for (int j = 0; j < 8; ++j) y[j] = v[j] * rstd * lgv[j] + lbv[j];
            u32x4 o; o.x = pk2(y[0], y[1]); o.y = pk2(y[2], y[3]); o.z = pk2(y[4], y[5]); o.w = pk2(y[6], y[7]);
            *(LAS u32x4*)(lds + SG_V + s * SGP + (lane & 15) * 16) = o; }
    }
    __syncthreads();
    {
        const int tb = wid; f32x4 acc[8];
        const int t = 16 * tb + r; const float bs = X.sgu_b[(size_t)(l * 4 + grp) * 128 + t];
        u32x2 suv[8];
#pragma unroll
        for (int cb = 0; cb < 8; ++cb) suv[cb] = *(const u32x2*)(X.proj + (row0 + t) * PP + SU + grp * 128 + 16 * cb + 4 * g);
#pragma unroll
        for (int cb = 0; cb < 8; ++cb) acc[cb] = (f32x4){0.f, 0.f, 0.f, 0.f};
#pragma unroll
        for (int ks = 0; ks < 4; ++ks) {
            if (32 * ks <= 16 * tb + 15) {
                const bf16x8 wf = ld128(lds + SG_W + (16 * tb + r) * SGP + (32 * ks + 8 * g) * 2); bf16x8 vfr[8];
#pragma unroll
                for (int cb = 0; cb < 8; ++cb) vfr[cb] = vtr2(lds + SG_V + (32 * ks + 8 * g + q4) * SGP + (16 * cb + 4 * p4) * 2, 4 * SGP);
                __builtin_amdgcn_sched_barrier(0);
#pragma unroll
                for (int cb = 0; cb < 8; ++cb) acc[cb] = MFMA16(vfr[cb], wf, acc[cb]);
                __builtin_amdgcn_sched_barrier(0);
            }
        }
#pragma unroll
        for (int cb = 0; cb < 8; ++cb) { const int ch = grp * 128 + 16 * cb + 4 * g; const u32x2 su = suv[cb];
            const float u0 = lo16(su.x), u1 = hi16(su.x), u2 = lo16(su.y), u3 = hi16(su.y);
            u32x2 w; w.x = pk2(u0 * (acc[cb][0] + bs), u1 * (acc[cb][1] + bs)); w.y = pk2(u2 * (acc[cb][2] + bs), u3 * (acc[cb][3] + bs));
            *(u32x2*)(X.mix + (row0 + t) * D + 1536 + ch) = w; }
    }
    __syncthreads();
}

#define XB_TMO      128
#define XB_XCNT(j)  (256  + 64 * (j))
#define XB_XSUB(j)  (1280 + 64 * (j))
#define XB_XGEN(j)  (2304 + 64 * (j))
#define XB_TOP      3328
#define XB_TOPGEN   3392
#define XCD_BAR_WORDS 3456
#define XB_SPIN_CAP (1u << 18)

__device__ __forceinline__ unsigned xb_ld(unsigned* p)              { return __hip_atomic_load(p, __ATOMIC_RELAXED, __HIP_MEMORY_SCOPE_AGENT); }
__device__ __forceinline__ unsigned xb_add(unsigned* p, unsigned v) { return __hip_atomic_fetch_add(p, v, __ATOMIC_RELAXED, __HIP_MEMORY_SCOPE_AGENT); }
__device__ __forceinline__ unsigned xb_xcc_id() { return (unsigned)__builtin_amdgcn_s_getreg((3 << 11) | 20) & 0xFu; }
#define XB_SPIN(cond, bar) do { unsigned _sp = 0; while (cond) { __builtin_amdgcn_s_sleep(1); \
    if ((++_sp & 255u) == 0u) { if (xb_ld(&(bar)[XB_TMO])) break; if (_sp > XB_SPIN_CAP) { atomicAdd(&(bar)[XB_TMO], 1u); break; } } } } while (0)

struct XcdBarrier {
    unsigned* bar; unsigned x;
    volatile LAS unsigned* st;
};

__device__ __forceinline__ XcdBarrier xcd_barrier_post(unsigned* bar, volatile LAS unsigned* st) {
    XcdBarrier b; b.bar = bar; b.x = xb_xcc_id(); b.st = st;
    if (threadIdx.x == 0) (void)xb_add(&bar[XB_XCNT(b.x)], 1u);
    return b;
}
__device__ __forceinline__ void xcd_barrier_complete(unsigned* bar, unsigned x, unsigned& nloc, unsigned& nx) {
    const unsigned G = gridDim.x * gridDim.y * gridDim.z;
    unsigned sum, cnt, mine, sp = 0u;
    for (;;) {
        sum = 0u; cnt = 0u; mine = 0u;
#pragma unroll
        for (unsigned j = 0; j < 16; ++j) { const unsigned c = xb_ld(&bar[XB_XCNT(j)]); sum += c; cnt += (c > 0u) ? 1u : 0u; mine = (j == x) ? c : mine; }
        if (sum == G) break;
        __builtin_amdgcn_s_sleep(1);
        if ((++sp & 255u) == 0u) { if (xb_ld(&bar[XB_TMO])) break; if (sp > XB_SPIN_CAP) { atomicAdd(&bar[XB_TMO], 1u); break; } }
    }
    nloc = mine > 0u ? mine : 1u; nx = cnt > 0u ? cnt : 1u;
}

__device__ __forceinline__ void xcd_barrier(const XcdBarrier& b, const bool glob = true) {
    asm volatile("s_waitcnt vmcnt(0)" ::: "memory");
    __syncthreads();
    if (threadIdx.x == 0) {
        unsigned* bar = b.bar;
        __builtin_amdgcn_s_waitcnt(0);
        unsigned nloc = b.st[0], nx = b.st[1];
        if (nloc == 0u) { xcd_barrier_complete(bar, b.x, nloc, nx); b.st[0] = nloc; b.st[1] = nx; }
        const unsigned old = xb_add(&bar[XB_XSUB(b.x)], 1u);
        const unsigned gen = old / nloc;
        if (old + 1u == (gen + 1u) * nloc) {
            if (glob) {
            __builtin_amdgcn_fence(__ATOMIC_RELEASE, "agent");
            asm volatile("s_waitcnt vmcnt(0)" ::: "memory");
            const unsigned og = xb_add(&bar[XB_TOP], 1u);
            const unsigned tg = og / nx;
            if (og + 1u == (tg + 1u) * nx) xb_add(&bar[XB_TOPGEN], 1u);
            else XB_SPIN(xb_ld(&bar[XB_TOPGEN]) == tg, bar);
            }
            __builtin_amdgcn_fence(__ATOMIC_ACQUIRE, "agent");
            xb_add(&bar[XB_XGEN(b.x)], 1u);
            asm volatile("s_waitcnt vmcnt(0)" ::: "memory");
        } else {
            XB_SPIN(xb_ld(&bar[XB_XGEN(b.x)]) == gen, bar);
            __builtin_amdgcn_fence(__ATOMIC_ACQUIRE, "agent");
            asm volatile("s_waitcnt vmcnt(0)" ::: "memory");
        }
    }
    __syncthreads();
}

#ifndef DIS_PRO
#define DIS_PRO 0
#endif
#ifndef DIS_G0
#define DIS_G0 0
#endif
#ifndef DIS_PRE
#define DIS_PRE 0
#endif
#ifndef DIS_SCAN
#define DIS_SCAN 0
#endif
#ifndef DIS_SGU
#define DIS_SGU 0
#endif
#ifndef DIS_G3
#define DIS_G3 0
#endif
#ifndef DIS_G5
#define DIS_G5 0
#endif
#ifndef DIS_G6
#define DIS_G6 0
#endif
#ifndef GRID_SYNC
#define GRID_SYNC() cg::this_grid().sync()
#endif
#ifndef DIS_NORM
#define DIS_NORM 0
#endif
#ifndef REP_SCAN
#define REP_SCAN 1
#endif
#ifndef REP_PRE
#define REP_PRE 1
#endif
#ifndef REP_PRO
#define REP_PRO 1
#endif
#ifndef REP_G0
#define REP_G0 1
#endif
#ifndef REP_G5
#define REP_G5 1
#endif
#ifndef REP_NORM
#define REP_NORM 1
#endif
#ifndef REP_SGU
#define REP_SGU 1
#endif
#ifndef REP_G3
#define REP_G3 1
#endif
struct Args { const float* in[19]; float* out; unsigned char* ws; int ph_lo, ph_hi; };
constexpr int N_PHASES = 2 + 6 * NL;
__global__ void __launch_bounds__(NT, 2) hymba_fwd(Args args) {
    extern __shared__ __attribute__((aligned(16))) unsigned char lds_raw[];
    LAS unsigned char* lds = (LAS unsigned char*)lds_raw;
    Ctx X;
    X.x = args.in[0]; X.norm_mix = args.in[1]; X.w_in = args.in[2]; X.gla_a2 = args.in[3]; X.gla_ab = args.in[4]; X.gla_norm = args.in[5]; X.ml_conv = args.in[6]; X.ml_ib = args.in[7];
    X.ml_fb = args.in[8]; X.ml_norm = args.in[9]; X.sgu_ln_g = args.in[10]; X.sgu_ln_b = args.in[11]; X.sgu_w = args.in[12]; X.sgu_b = args.in[13]; X.w_out = args.in[14]; X.norm_ffn = args.in[15];
    X.w_gu = args.in[16]; X.w_down = args.in[17]; X.norm_final = args.in[18]; X.out = args.out; X.ws = args.ws;
    X.xn = (bf16*)(args.ws + WS_XN); X.proj = (bf16*)(args.ws + WS_PROJ); X.act = (bf16*)(args.ws + WS_PROJ); X.mix = (bf16*)(args.ws + WS_MIX);
    X.qg = (bf16*)(args.ws + WS_QG); X.kg = (bf16*)(args.ws + WS_KG); X.qm = (bf16*)(args.ws + WS_QM); X.km = (bf16*)(args.ws + WS_KM);
    X.elast = (float*)(args.ws + WS_ELAST); X.cumf = (float*)(args.ws + WS_CUMF); X.pmx = (float*)(args.ws + WS_PMX);
    const int G = gridDim.x, bx = blockIdx.x, ngw = G * NWAVES;
    const int lo = args.ph_lo, hi = args.ph_hi;
#define IN(k) (lo <= (k) && (k) < hi)
    if (threadIdx.x < 16) ((LAS unsigned*)(lds + LDS_CTL_OFF))[threadIdx.x] = 0u;
    __syncthreads();
    const XcdBarrier xbar = xcd_barrier_post((unsigned*)(args.ws + WS_CTL), (volatile LAS unsigned*)(lds + LDS_CTL_OFF));
    if (threadIdx.x == 0) { unsigned* ctl_ = (unsigned*)(args.ws + WS_CTL); const unsigned x_ = xb_xcc_id();
        const unsigned rk_ = __hip_atomic_fetch_add(ctl_ + 3584 + x_, 1u, __ATOMIC_RELAXED, __HIP_MEMORY_SCOPE_AGENT);
        if (rk_ >= 32u || x_ >= 8u || G != 256) __hip_atomic_store(ctl_ + 3616, 1u, __ATOMIC_RELAXED, __HIP_MEMORY_SCOPE_AGENT);
        ((volatile LAS unsigned*)(lds + LDS_CTL_OFF))[4] = rk_ * 8u + x_; }
#define SEAM(k) do { if (IN(k) && IN((k) + 1)) { if ((k) == 0) GRID_SYNC(); else xcd_barrier(xbar); } } while (0)
#define SEAML(k) do { if (IN(k) && IN((k) + 1)) xcd_barrier(xbar, !xloc); } while (0)
    unsigned long long* ssq = (unsigned long long*)(args.ws + WS_SSQ);
    if (IN(0) && !DIS_PRO) for (int rep_ = 0; rep_ < REP_PRO; ++rep_) {
        for (int i = bx * NT + (int)threadIdx.x; i < 4 * M; i += G * NT) ssq[M + i] = 0ull;
        convert_weights(X, lds, bx * NWAVES, ngw, 0, I_IN + I_OUT + I_GU); rows_bf16_ssq(X.x, X.xn, ssq, bx * NWAVES, ngw); }
    SEAM(0);
    int cx = bx;
    { const unsigned bad_ = __hip_atomic_load((unsigned*)(args.ws + WS_CTL) + 3616, __ATOMIC_RELAXED, __HIP_MEMORY_SCOPE_AGENT);
      const int c_ = (int)((volatile LAS unsigned*)(lds + LDS_CTL_OFF))[4]; if (!bad_) cx = __builtin_amdgcn_readfirstlane(c_); }
    const bool xloc = (cx != bx) || (G == 256 && __hip_atomic_load((unsigned*)(args.ws + WS_CTL) + 3616, __ATOMIC_RELAXED, __HIP_MEMORY_SCOPE_AGENT) == 0u);
    const int xb_ = cx & 7, xj_ = cx >> 3;
    for (int l = 0; l < NL; ++l) {
        const int pb = 1 + 6 * l; unsigned char* wl = args.ws + (size_t)l * WS_LAYER;
        const float* xin = (l == 0) ? X.x : X.out;
        if (IN(pb + 0) && !DIS_G0) for (int rep_ = 0; rep_ < REP_G0; ++rep_) { pg8::Gemm gm{X.xn, (const bf16*)(wl + WS_WIN), M, PP, D}; pg8::StaticOrder S; S.init(M, PP, G, cx);
            pg8::EpiProj E{X.proj, PP, X.gla_norm + l * 768, X.ml_norm + l * 768, ssq + (size_t)(2 * l) * M, 1.0f / D, EPS};
            pg8::gemm_phase<pg8::EpiProj, pg8::StaticOrder, true, true>(lds, gm, S, E); }
        SEAML(pb + 0);
        if (IN(pb + 1) && !DIS_PRE) for (int rep_ = 0; rep_ < REP_PRE; ++rep_) { if (xloc) prepass_item(X, l, xb_ * 32 + xj_, lds); else for (int it = bx; it < 256; it += G) prepass_item(X, l, it, lds); }
        SEAML(pb + 1);
        if (IN(pb + 2)) for (int rep_ = 0; rep_ < REP_SCAN; ++rep_) {
            if (xloc) {
                if (xj_ < 8) { if (xj_ & 1) scan_item<true>(X, l, xb_, xj_ >> 1, lds); else scan_item<false>(X, l, xb_, xj_ >> 1, lds); }
                else { for (int it = xj_ - 8; it < 64; it += 24) sgu_item(X, l, xb_ * 64 + it, lds);
                    if (rep_ == 0) convert_weights(X, lds, (xb_ * 24 + xj_ - 8) * NWAVES, 192 * NWAVES, l == 0 ? I_IN + I_OUT + I_GU : I_L + I_IN + I_OUT, l == 0 ? I_L + I_IN + I_OUT : 2 * I_L); }
            } else {
            if (DIS_SCAN) {} else if (bx < 64) { if (bx & 1) scan_item<true>(X, l, bx >> 3, (bx >> 1) & 3, lds); else scan_item<false>(X, l, bx >> 3, (bx >> 1) & 3, lds); }
            else if (!DIS_SGU) for (int rs_ = 0; rs_ < REP_SGU; ++rs_) { for (int it = bx - 64; it < 512; it += G - 64) sgu_item(X, l, it, lds); }
            if (bx >= 64 && rep_ == 0) convert_weights(X, lds, (bx - 64) * NWAVES, (G - 64) * NWAVES, l == 0 ? I_IN + I_OUT + I_GU : I_L + I_IN + I_OUT, l == 0 ? I_L + I_IN + I_OUT : 2 * I_L);
            }
        }
        SEAM(pb + 2);
        if (IN(pb + 3) && !DIS_G3) { pg8::Gemm gm{X.mix, (const bf16*)(wl + WS_WOUT), M, D, D}; pg8::StaticOrder S; S.init(M, D, G, cx); pg8::EpiResid E{nullptr, nullptr, D, X.xn, ssq + (size_t)(2 * l + 1) * M};
            pg8::gemm_phase<pg8::EpiResid, pg8::StaticOrder, true, true>(lds, gm, S, E); }
        SEAML(pb + 3);
        if (IN(pb + 4) && !DIS_G5) for (int rep_ = 0; rep_ < REP_G5; ++rep_) { pg8::Gemm gm{X.xn, (const bf16*)(wl + WS_WGU), M, NGU, D}; pg8::StaticOrder S; S.init(M, NGU, G, cx);
            pg8::EpiSwiGLU E{X.act, FF, ssq + (size_t)(2 * l + 1) * M, 1.0f / D, EPS};
            pg8::gemm_phase<pg8::EpiSwiGLU, pg8::StaticOrder, true, true>(lds, gm, S, E); }
        SEAML(pb + 4);
        if (IN(pb + 5) && !DIS_G6) { pg8::Gemm gm{X.act, (const bf16*)(wl + WS_WDN), M, D, FF}; pg8::StaticOrder S; S.init(M, D, G, cx); pg8::EpiResid E{nullptr, nullptr, D, X.xn, ssq + (size_t)(2 * l + 2) * M};
            pg8::gemm_phase<pg8::EpiResid, pg8::StaticOrder, true, true>(lds, gm, S, E); }
        if (l + 1 < NL) SEAM(pb + 5); else SEAML(pb + 5);
    }
    if (IN(1 + 6 * NL) && !DIS_NORM) {
        if (xloc) { const size_t r0 = (size_t)xb_ * SEQ;
            rows_final_norm(X.xn + r0 * D, X.out + r0 * D, X.norm_final, ssq + (size_t)4 * M + r0, xj_ * NWAVES, 32 * NWAVES, SEQ); }
        else rows_final_norm(X.xn, X.out, X.norm_final, ssq + (size_t)4 * M, bx * NWAVES, ngw, M);
    }
#undef IN
#undef SEAM
}

#ifndef MK_ONE_LAUNCH
#define MK_ONE_LAUNCH 1
#endif
extern "C" void kernel_launch(void* const* d_in, const int* in_sizes, int n_in, void* d_out, int out_size, void* d_ws, size_t ws_size, hipStream_t stream) {
    static int grid = 0;
    if (grid == 0) {
        if (n_in != 19 || out_size != M * D || ws_size < WS_END) { fprintf(stderr, "kernel_launch: unexpected shapes (n_in %d out %d ws %zu)\n", n_in, out_size, ws_size); grid = -1; return; }
        int dev = 0, cus = 0, per_cu = 0;
        hipGetDevice(&dev); hipDeviceGetAttribute(&cus, hipDeviceAttributeMultiprocessorCount, dev);
        if (hipFuncSetAttribute((const void*)hymba_fwd, hipFuncAttributeMaxDynamicSharedMemorySize, LDS_BYTES) != hipSuccess) { fprintf(stderr, "kernel_launch: hipFuncSetAttribute failed\n"); grid = -1; return; }
        if (hipOccupancyMaxActiveBlocksPerMultiprocessor(&per_cu, (const void*)hymba_fwd, NT, LDS_BYTES) != hipSuccess || per_cu < 1) { fprintf(stderr, "kernel_launch: occupancy query gave %d\n", per_cu); per_cu = 1; }
        (void)hipGetLastError();
        grid = cus * 1;
        if (grid > cus * per_cu) grid = cus * per_cu;
    }
    if (grid < 0) return;
    if (hipMemsetAsync((char*)d_ws + WS_CTL, 0, CTL_BYTES, stream) != hipSuccess) { fprintf(stderr, "kernel_launch: memset failed\n"); return; }
    Args a{};
    for (int i = 0; i < 19; ++i) a.in[i] = (const float*)d_in[i];
    a.out = (float*)d_out; a.ws = (unsigned char*)d_ws;
#if MK_ONE_LAUNCH
    a.ph_lo = 0; a.ph_hi = N_PHASES;
    void* kargs[] = {&a};
    hipError_t e = hipLaunchCooperativeKernel((const void*)hymba_fwd, dim3(grid), dim3(NT), kargs, LDS_BYTES, stream);
    if (e != hipSuccess) fprintf(stderr, "kernel_launch: cooperative launch failed: %s (grid %d)\n", hipGetErrorString(e), grid);
#else
    for (int p = 0; p < N_PHASES; ++p) { a.ph_lo = p; a.ph_hi = p + 1; hipLaunchKernelGGL(hymba_fwd, dim3(grid), dim3(NT), LDS_BYTES, stream, a); }
#endif
}
```
